# Optimizing an MI355X kernel written in HIP

```python
import jax, jax.numpy as jnp
from jax import lax
import numpy as np

D_MODEL = 1024
BATCH = 4
SEQ = 4096
DEPTH = 1

CHUNK = 64
Q_BLOCK = 128
D_MIX = D_MODEL
A_HEADS = 8
A_HEAD_DIM = 64
A_WIDTH = A_HEADS * A_HEAD_DIM
IDX_HEADS = 4
IDX_DIM = 64
TOPK_MAX = 256
B_HEADS = 4
B_KEY_DIM = 64
B_VAL_DIM = 128
B_WIDTH = B_HEADS * B_VAL_DIM
ROPE_THETA = 500000.0
ROT_DIM = A_HEAD_DIM // 4
N_EXPERTS = 32
TOP_K_EXPERTS = 4
D_EXPERT = D_MODEL
SWIGLU_LIMIT = 7.0
SWIGLU_ALPHA = 1.702
EXPERT_BLOCK = 256
RMS_EPS = 1e-6

SPLITS = (A_WIDTH, A_WIDTH, A_WIDTH,
          IDX_HEADS * IDX_DIM, IDX_DIM, IDX_HEADS,
          B_HEADS * B_KEY_DIM, B_HEADS * B_KEY_DIM,
          B_WIDTH, B_WIDTH)
D_IN = sum(SPLITS)
SPLIT_POINTS = tuple(int(v) for v in np.cumsum(SPLITS)[:-1])

kernel_name = "hybrid_dsa_hgrn2_moe_adaln_block"

F32 = jnp.float32


def rmsnorm(x, g):
    xf = x.astype(F32)
    y = xf * lax.rsqrt(jnp.mean(xf * xf, axis=-1, keepdims=True) + RMS_EPS)
    return (y * g.astype(F32)).astype(x.dtype)


def rope_tables(positions):
    inv_freq = ROPE_THETA ** (-(jnp.arange(0, ROT_DIM, 2, dtype=F32) / ROT_DIM))
    ang = positions.astype(F32)[..., None] * inv_freq
    return jnp.cos(ang)[:, :, None, :], jnp.sin(ang)[:, :, None, :]


def apply_partial_rope(x, cos, sin):
    r = cos.shape[-1]
    x1, x2, rest = x[..., :r], x[..., r:2 * r], x[..., 2 * r:]
    xf1, xf2 = x1.astype(F32), x2.astype(F32)
    rot = jnp.concatenate([xf1 * cos - xf2 * sin, xf2 * cos + xf1 * sin], axis=-1)
    return jnp.concatenate([rot.astype(x.dtype), rest], axis=-1)


def dsa_attention(q, k, v, qi, ki, wi):
    B, S = q.shape[0], q.shape[1]
    topk = min(TOPK_MAX, S // 4)
    nqb = S // Q_BLOCK
    key_chunk = jnp.arange(S) // CHUNK
    scale = A_HEAD_DIM ** -0.5

    def blocks(a):
        return jnp.swapaxes(a.reshape((B, nqb, Q_BLOCK) + a.shape[2:]), 0, 1)

    def one_block(args):
        n, qb, qib, wib = args
        q_chunk = (n * Q_BLOCK + jnp.arange(Q_BLOCK)) // CHUNK
        logits = jnp.einsum('bqhd,bsd->bqhs', qib, ki) * (IDX_DIM ** -0.5)
        score = jnp.einsum('bqh,bqhs->bqs', wib, jax.nn.relu(logits)).astype(F32)
        admissible = key_chunk[None, :] <= q_chunk[:, None]
        score = jnp.where(admissible[None], score, -jnp.inf)
        _, idx = lax.top_k(score, topk)
        valid = (idx // CHUNK) <= q_chunk[None, :, None]
        k_sel = jax.vmap(lambda kb, ib: kb[ib])(k, idx)
        v_sel = jax.vmap(lambda vb, ib: vb[ib])(v, idx)
        s = jnp.einsum('bqhd,bqkhd->bqhk', qb, k_sel).astype(F32) * scale
        s = jnp.where(valid[:, :, None, :], s, -jnp.inf)
        p = jax.nn.softmax(s, axis=-1).astype(v.dtype)
        return jnp.einsum('bqhk,bqkhd->bqhd', p, v_sel)

    out = lax.map(one_block, (jnp.arange(nqb), blocks(q), blocks(qi), blocks(wi)))
    return jnp.swapaxes(out, 0, 1).reshape(B, S, -1)


def hgrn2_chunkwise(q, log_f, k, v):
    B, S, H, dk = q.shape
    dv = v.shape[-1]
    nc = S // CHUNK

    def to_chunks(a):
        return a.astype(F32).reshape(B, nc, CHUNK, H, a.shape[-1]).transpose(1, 0, 3, 2, 4)

    tri = jnp.tril(jnp.ones((CHUNK, CHUNK), bool))[:, :, None]

    def step(state, inp):
        qc, lfc, kc, vc = inp
        b = jnp.cumsum(lfc, axis=2)
        o_inter = jnp.einsum('bhtd,bhde->bhte', qc * jnp.exp(b), state)
        diff = b[:, :, :, None, :] - b[:, :, None, :, :]
        decay = jnp.exp(jnp.where(tri, diff, -jnp.inf))
        attn = jnp.einsum('bhtd,bhsd,bhtsd->bhts', qc, kc, decay)
        o_intra = jnp.einsum('bhts,bhse->bhte', attn, vc)
        b_last = b[:, :, -1:, :]
        new_state = (jnp.exp(b_last[:, :, 0, :])[..., None] * state
                     + jnp.einsum('bhsd,bhse->bhde', kc * jnp.exp(b_last - b), vc))
        return new_state, o_inter + o_intra

    s0 = jnp.zeros((B, H, dk, dv), F32)
    _, o = lax.scan(step, s0, (to_chunks(q), to_chunks(log_f), to_chunks(k), to_chunks(v)))
    return o.transpose(1, 0, 3, 2, 4).reshape(B, S, H, dv)


def moe_ffn(h, router_w, router_b, w1, b1, w2, b2):
    B, S, D = h.shape
    T = B * S
    xt = h.reshape(T, D)
    logits = (xt @ router_w + router_b).astype(F32)
    top_vals, top_idx = lax.top_k(logits, TOP_K_EXPERTS)
    gates = jax.nn.softmax(top_vals, axis=-1)

    n_assign = T * TOP_K_EXPERTS
    e_flat = top_idx.reshape(-1).astype(jnp.int32)
    tok_flat = jnp.arange(n_assign, dtype=jnp.int32) // TOP_K_EXPERTS
    order = jnp.argsort(e_flat)
    e_sorted = e_flat[order]
    tok_sorted = tok_flat[order]
    counts = jnp.bincount(e_flat, length=N_EXPERTS).astype(jnp.int32)
    padded = (counts + EXPERT_BLOCK - 1) // EXPERT_BLOCK * EXPERT_BLOCK
    start = jnp.cumsum(counts) - counts
    pad_end = jnp.cumsum(padded)
    pad_start = pad_end - padded
    row = pad_start[e_sorted] + jnp.arange(n_assign, dtype=jnp.int32) - start[e_sorted]
    n_blocks = -(-n_assign // EXPERT_BLOCK) + N_EXPERTS
    n_rows = n_blocks * EXPERT_BLOCK
    row_tok = jnp.full((n_rows,), T, jnp.int32).at[row].set(tok_sorted)
    x_rows = jnp.concatenate([xt, jnp.zeros((1, D), xt.dtype)], axis=0)[row_tok]
    x_rows = x_rows.reshape(n_blocks, EXPERT_BLOCK, D)
    block_start = jnp.arange(n_blocks, dtype=jnp.int32) * EXPERT_BLOCK
    block_expert = jnp.minimum(jnp.searchsorted(pad_end, block_start, side='right'),
                               N_EXPERTS - 1).astype(jnp.int32)

    def expert_block(args):
        xb, e = args
        hg = xb @ w1[e] + b1[e]
        glu, lin = jnp.split(hg, 2, axis=-1)
        glu = jnp.minimum(glu, SWIGLU_LIMIT)
        lin = jnp.clip(lin, -SWIGLU_LIMIT, SWIGLU_LIMIT)
        act = glu * jax.nn.sigmoid(SWIGLU_ALPHA * glu) * (lin + 1)
        return act @ w2[e] + b2[e]

    y_rows = lax.map(expert_block, (x_rows, block_expert)).reshape(n_rows, D)
    row_orig = jnp.zeros((n_assign,), jnp.int32).at[order].set(row)
    y = y_rows[row_orig].reshape(T, TOP_K_EXPERTS, D)
    out = jnp.einsum('tk,tkd->td', gates.astype(y.dtype), y)
    return out.reshape(B, S, D)


def setup_inputs(seed: int = 0) -> dict:
    key = jax.random.key(seed)
    ks = jax.random.split(key, 20)
    D, F = D_MODEL, D_EXPERT
    nrm = jax.random.normal
    x = nrm(ks[0], (BATCH, SEQ, D), F32)
    c = nrm(ks[1], (BATCH, D), F32)
    offset = jax.random.randint(ks[2], (BATCH, 1), 0, 65536, dtype=jnp.int32)
    positions = (offset + jnp.arange(SEQ, dtype=jnp.int32)[None, :]).astype(jnp.int32)
    ada_w = nrm(ks[3], (DEPTH, D, 6 * D), F32) * (0.5 * D ** -0.5)
    ada_b = nrm(ks[4], (DEPTH, 6 * D), F32) * 0.02
    norm1_g = 1.0 + 0.02 * nrm(ks[5], (DEPTH, D), F32)
    w_in = nrm(ks[6], (DEPTH, D, D_IN), F32) * D ** -0.5
    hg_norm_g = 1.0 + 0.02 * nrm(ks[7], (DEPTH, B_VAL_DIM), F32)
    lb_logits = 0.5 * nrm(ks[8], (DEPTH + 1, B_HEADS * B_KEY_DIM), F32)
    w_out = nrm(ks[9], (DEPTH, D_MIX, D), F32) * D_MIX ** -0.5
    norm2_g = 1.0 + 0.02 * nrm(ks[10], (DEPTH, D), F32)
    router_w = nrm(ks[11], (DEPTH, D, N_EXPERTS), F32) * D ** -0.5
    router_b = 0.01 * nrm(ks[12], (DEPTH, N_EXPERTS), F32)
    moe_w1 = nrm(ks[13], (DEPTH, N_EXPERTS, D, 2 * F), F32) * D ** -0.5
    moe_b1 = 0.01 * nrm(ks[14], (DEPTH, N_EXPERTS, 2 * F), F32)
    moe_w2 = nrm(ks[15], (DEPTH, N_EXPERTS, F, D), F32) * F ** -0.5
    moe_b2 = 0.01 * nrm(ks[16], (DEPTH, N_EXPERTS, D), F32)
    final_g = 1.0 + 0.02 * nrm(ks[17], (D,), F32)
    return {"x": x, "c": c, "positions": positions, "ada_w": ada_w, "ada_b": ada_b,
            "norm1_g": norm1_g, "w_in": w_in, "hg_norm_g": hg_norm_g, "lb_logits": lb_logits,
            "w_out": w_out, "norm2_g": norm2_g, "router_w": router_w, "router_b": router_b,
            "moe_w1": moe_w1, "moe_b1": moe_b1, "moe_w2": moe_w2, "moe_b2": moe_b2,
            "final_g": final_g}


def reference(x, c, positions, ada_w, ada_b, norm1_g, w_in, hg_norm_g, lb_logits,
              w_out, norm2_g, router_w, router_b, moe_w1, moe_b1, moe_w2, moe_b2, final_g):
    B, S, _ = x.shape
    cos, sin = rope_tables(positions)
    lower_bounds = jnp.cumsum(jax.nn.softmax(lb_logits.astype(F32), axis=0), axis=0)

    for layer in range(DEPTH):
        mod = jax.nn.silu(c) @ ada_w[layer] + ada_b[layer]
        shift1, scale1, gate1, shift2, scale2, gate2 = [m[:, None, :] for m in jnp.split(mod, 6, axis=-1)]

        h = rmsnorm(x, norm1_g[layer]) * (1 + scale1) + shift1
        proj = h @ w_in[layer]
        qa, ka, va, qi, ki, wi, qb, fb, ib, gb = jnp.split(proj, SPLIT_POINTS, axis=-1)

        qa = apply_partial_rope(qa.reshape(B, S, A_HEADS, A_HEAD_DIM), cos, sin)
        ka = apply_partial_rope(ka.reshape(B, S, A_HEADS, A_HEAD_DIM), cos, sin)
        va = va.reshape(B, S, A_HEADS, A_HEAD_DIM)
        qi = apply_partial_rope(qi.reshape(B, S, IDX_HEADS, IDX_DIM), cos, sin)
        ki = apply_partial_rope(ki[:, :, None, :], cos, sin)[:, :, 0, :]
        wi = wi * (IDX_HEADS ** -0.5)
        out_a = dsa_attention(qa, ka, va, qi, ki, wi)

        lb = lower_bounds[layer]
        f = lb + (1.0 - lb) * jax.nn.sigmoid(fb.astype(F32))
        log_f = jnp.log(f).reshape(B, S, B_HEADS, B_KEY_DIM)
        k_in = (1.0 - f).reshape(B, S, B_HEADS, B_KEY_DIM)
        o_b = hgrn2_chunkwise(qb.reshape(B, S, B_HEADS, B_KEY_DIM), log_f, k_in,
                              ib.reshape(B, S, B_HEADS, B_VAL_DIM))
        o_b = rmsnorm(o_b, hg_norm_g[layer]).astype(x.dtype)
        out_b = (o_b * jax.nn.silu(gb.reshape(B, S, B_HEADS, B_VAL_DIM))).reshape(B, S, B_WIDTH)

        mix = jnp.concatenate([out_a.astype(x.dtype), out_b], axis=-1)
        x = x + gate1 * (mix @ w_out[layer])

        h2 = rmsnorm(x, norm2_g[layer]) * (1 + scale2) + shift2
        x = x + gate2 * moe_ffn(h2, router_w[layer], router_b[layer], moe_w1[layer],
                                moe_b1[layer], moe_w2[layer], moe_b2[layer])

    return rmsnorm(x, final_g)
```

```cpp
#include <hip/hip_runtime.h>
#include <stdint.h>
#include <hip/hip_cooperative_groups.h>
#include <cstdio>
namespace cg = cooperative_groups;
constexpr int NB = 4, S = 4096, D = 1024, T = NB * S;
constexpr int DIN = 3396;
constexpr int NE = 32, NROWS = (T * 4 / 256 + NE) * 256;
constexpr size_t MiB = 1u << 20;
namespace pg8 {
#define PG8_LAS __attribute__((address_space(3)))
typedef unsigned short bf16_t;
typedef short bf16x8 __attribute__((ext_vector_type(8)));
typedef float f32x4 __attribute__((ext_vector_type(4)));
typedef unsigned u32x4 __attribute__((ext_vector_type(4)));
constexpr int BM = 256, BK = 64, HALF = 128, HTB = HALF * BK * 2  , STAGE_BYTES = 8 * HTB, NXCD = 8, WGM = 8;

__host__ __device__ __forceinline__ int lds_byte(int r, int c) { const int st = (r >> 4) * 2 + (c >> 5), rr = r & 15, cc = c & 31, ob = rr * 64 + cc * 2; return st * 1024 + (ob ^ (((ob >> 9) & 1) << 5)); }
__host__ __device__ __forceinline__ void stage_rc(int b, int& R, int& C) { const int st = b / 1024, sb = b % 1024, swz = sb ^ (((sb >> 9) & 1) << 5); R = (st >> 1) * 16 + swz / 64; C = (st & 1) * 32 + (swz % 64) / 2; }
__host__ __device__ __forceinline__ int perm32(int rho) { const int n = rho >> 4, i = rho & 15; return 8 * (i >> 2) + 4 * n + (i & 3); }

struct Unit { int pm, pn; };
struct Gemm { const bf16_t* A; const bf16_t* Bt; int M, N, K; };

struct StaticOrder {
    static constexpr bool GATHER = false; const int* tok = nullptr;
    int nM, nN, nwg, G, c;
    __host__ __device__ void init(int M, int N, int G_, int c_) { nM = M / BM; nN = N / BM; nwg = nM * nN; G = G_; c = c_; }
    __host__ __device__ bool next(int i, Unit& u) const {
        const long L = (long)i * G + c; if (L >= nwg) return false;
        int wgid = (int)L; { const int q = nwg / NXCD, r = nwg % NXCD, xcd = wgid % NXCD, off = wgid / NXCD; wgid = (xcd < r ? xcd * (q + 1) : r * (q + 1) + (xcd - r) * q) + off; }
        const int nig = WGM * nN, gid = wgid / nig, fm = gid * WGM, gsz = (nM - fm) < WGM ? (nM - fm) : WGM;
        u.pm = fm + ((wgid % nig) % gsz); u.pn = (wgid % nig) / gsz; return true;
    }
    __device__ __forceinline__ void a_ready(const Unit&) const {}
    __device__ __forceinline__ void done(const Unit&) const {}
};
__device__ __forceinline__ unsigned cvt_pk_bf16(float lo, float hi) { unsigned r; asm volatile("v_cvt_pk_bf16_f32 %0, %1, %2" : "=v"(r) : "v"(lo), "v"(hi)); return r; }
typedef float f32x2 __attribute__((ext_vector_type(2)));
template <class Epi, class Sched, bool ALIGN_EPI = false, bool SP2 = false>
__device__ __forceinline__ void gemm_phase(PG8_LAS unsigned char* lds, const Gemm g, const Sched& S, const Epi& E) {
    const int tid = threadIdx.x, wid = __builtin_amdgcn_readfirstlane(tid >> 6), lane = tid & 63, wr = wid >> 2, wc = wid & 3, fr = lane & 15, fq = lane >> 4;
    const int K = g.K, nt = K / BK;
    unsigned voffA[2], voffB[2]; int RA[2], CA[2];
#pragma unroll
    for (int i = 0; i < 2; ++i) { int R, C; stage_rc(tid * 16 + i * 8192, R, C); const int Rb = Epi::PERM ? ((R & ~31) + perm32(R & 31)) : R; RA[i] = R; CA[i] = C;
        voffA[i] = (unsigned)(R * K + C) * 2u; voffB[i] = (unsigned)(Rb * K + C) * 2u; }
    unsigned oc0[2], oc1[2], on0[2], on1[2];
#define PG8_OFFS(u, o0, o1) do { _Pragma("unroll") for (int i_ = 0; i_ < 2; ++i_) { \
        if constexpr (Sched::GATHER) { o0[i_] = (unsigned)S.tok[(u).pm * 256 + RA[i_]] * (unsigned)(K * 2) + (unsigned)CA[i_] * 2u; o1[i_] = (unsigned)S.tok[(u).pm * 256 + 128 + RA[i_]] * (unsigned)(K * 2) + (unsigned)CA[i_] * 2u; } \
        else { o0[i_] = voffA[i_]; o1[i_] = voffA[i_] + (unsigned)(HALF * K * 2); } } } while (0)
    const size_t kstep = (size_t)(BK * 2);
    const size_t hstep = (size_t)HALF * K * 2;
    const size_t tstep = 2 * hstep;
    const unsigned ldsw = (unsigned)wid * 1024u;
    const int aoff = lds_byte(wr * 64 + fr, fq * 8), boff = lds_byte(wc * 32 + fr, fq * 8);
#define PG8_SA(b, h) (((b) * 2 + (h)) * HTB)
#define PG8_SB(b, h) ((4 + (b) * 2 + (h)) * HTB)
#define PG8_STAGE(bufoff, gbase, voff) do { _Pragma("unroll") for (int _i = 0; _i < 2; ++_i) \
        __builtin_amdgcn_global_load_lds((const unsigned*)((const char*)(gbase) + (voff)[_i]), (PG8_LAS unsigned*)(lds + (bufoff) + ldsw + _i * 8192), 16, 0, 0); } while (0)
#define PG8_LDA(dst, b, h) do { _Pragma("unroll") for (int m = 0; m < 4; ++m) _Pragma("unroll") for (int k = 0; k < 2; ++k) dst[m][k] = *(const PG8_LAS bf16x8*)(lds + PG8_SA(b, h) + aoff + m * 2048 + k * 1024); } while (0)
#define PG8_LDB(dst, b, h) do { _Pragma("unroll") for (int n = 0; n < 2; ++n) _Pragma("unroll") for (int k = 0; k < 2; ++k) dst[n][k] = *(const PG8_LAS bf16x8*)(lds + PG8_SB(b, h) + boff + n * 2048 + k * 1024); } while (0)
#define PG8_MMA(ai, bj, At, Bt) do { __builtin_amdgcn_s_setprio(1); _Pragma("unroll") for (int m = 0; m < 4; ++m) _Pragma("unroll") for (int n = 0; n < 2; ++n) _Pragma("unroll") for (int k = 0; k < 2; ++k) \
        acc[ai][bj][m][n] = __builtin_amdgcn_mfma_f32_16x16x32_bf16(Bt[n][k], At[m][k], acc[ai][bj][m][n], 0, 0, 0); __builtin_amdgcn_s_setprio(0); } while (0)
#define PG8_WAIT_V(n) asm volatile("s_waitcnt vmcnt(" #n ")" ::: "memory")
#define PG8_WAIT_L(n) asm volatile("s_waitcnt lgkmcnt(" #n ")" ::: "memory")
#define PG8_BAR __builtin_amdgcn_s_barrier()
#define PG8_SCHED __builtin_amdgcn_sched_barrier(0)
    Unit cur, nxt; int ui = 0;
    if (!S.next(0, cur)) return;
    f32x4 acc[2][2][4][2];
#pragma unroll
    for (int a = 0; a < 2; ++a)
#pragma unroll
        for (int b = 0; b < 2; ++b)
#pragma unroll
            for (int m = 0; m < 4; ++m)
#pragma unroll
                for (int n = 0; n < 2; ++n) acc[a][b][m][n] = (f32x4){0.f, 0.f, 0.f, 0.f};
    bf16x8 At[4][2], B0[2][2], B1[2][2];
    const char* cA = (const char*)g.A + (Sched::GATHER ? (size_t)0 : (size_t)cur.pm * tstep); const char* cB = (const char*)g.Bt + (size_t)cur.pn * tstep;
    PG8_OFFS(cur, oc0, oc1);
    S.a_ready(cur);
    if constexpr (SP2) {
        PG8_STAGE(PG8_SB(0, 0), cB, voffB); PG8_STAGE(PG8_SB(0, 1), cB + hstep, voffB); PG8_STAGE(PG8_SA(0, 0), cA, oc0); PG8_STAGE(PG8_SA(0, 1), cA, oc1);
        if (wr == 1) PG8_BAR;
        PG8_WAIT_V(2); PG8_BAR;
        PG8_STAGE(PG8_SB(1, 0), cB + kstep, voffB); PG8_STAGE(PG8_SA(1, 0), cA + kstep, oc0); PG8_STAGE(PG8_SB(1, 1), cB + hstep + kstep, voffB);
        PG8_WAIT_V(6); PG8_BAR;
    } else {
        PG8_STAGE(PG8_SB(0, 0), cB, voffB); PG8_STAGE(PG8_SA(0, 0), cA, oc0); PG8_STAGE(PG8_SB(0, 1), cB + hstep, voffB); PG8_STAGE(PG8_SA(0, 1), cA, oc1);
        if (wr == 1) PG8_BAR;
        PG8_WAIT_V(4); PG8_BAR;
        PG8_STAGE(PG8_SB(1, 0), cB + kstep, voffB); PG8_STAGE(PG8_SA(1, 0), cA + kstep, oc0); PG8_STAGE(PG8_SB(1, 1), cB + hstep + kstep, voffB);
        PG8_WAIT_V(6); PG8_BAR;
    }
    for (;;) {
        const bool has_next = S.next(ui + 1, nxt);
        const char* nA = has_next ? (const char*)g.A + (Sched::GATHER ? (size_t)0 : (size_t)nxt.pm * tstep) : cA;
        if (has_next) PG8_OFFS(nxt, on0, on1); else { on0[0] = oc0[0]; on0[1] = oc0[1]; on1[0] = oc1[0]; on1[1] = oc1[1]; }
        const char* nB = has_next ? (const char*)g.Bt + (size_t)nxt.pn * tstep : cB;
        for (int t = 0; t < nt; t += 2) {
            const bool last = (t == nt - 2);
            const char* a1 = cA + (size_t)(t + 1) * kstep;
            const char* a2 = last ? nA : cA + (size_t)(t + 2) * kstep; const char* b2 = last ? nB : cB + (size_t)(t + 2) * kstep;
            const char* a3 = a2 + kstep; const char* b3 = b2 + kstep;
            const unsigned x0[2] = {last ? on0[0] : oc0[0], last ? on0[1] : oc0[1]}, x1[2] = {last ? on1[0] : oc1[0], last ? on1[1] : oc1[1]};
            if (last && has_next) S.a_ready(nxt);
            if constexpr (SP2) {
            PG8_LDB(B0, 0, 0); PG8_LDB(B1, 0, 1); PG8_SCHED; PG8_LDA(At, 0, 0); PG8_STAGE(PG8_SA(1, 1), a1, oc1);
            PG8_WAIT_V(8); PG8_WAIT_L(0); PG8_BAR; PG8_MMA(0, 0, At, B0); PG8_MMA(0, 1, At, B1); PG8_BAR; PG8_SCHED;
            PG8_LDA(At, 0, 1); PG8_STAGE(PG8_SB(0, 0), b2, voffB); PG8_STAGE(PG8_SB(0, 1), b2 + hstep, voffB); PG8_STAGE(PG8_SA(0, 0), a2, x0);
            PG8_WAIT_V(8); PG8_WAIT_L(0); PG8_BAR; PG8_MMA(1, 0, At, B0); PG8_MMA(1, 1, At, B1); PG8_BAR; PG8_SCHED;
            PG8_LDB(B0, 1, 0); PG8_LDB(B1, 1, 1); PG8_SCHED; PG8_LDA(At, 1, 0); PG8_STAGE(PG8_SA(0, 1), a2, x1);
            PG8_WAIT_V(8); PG8_WAIT_L(0); PG8_BAR; PG8_MMA(0, 0, At, B0); PG8_MMA(0, 1, At, B1); PG8_BAR; PG8_SCHED;
            PG8_LDA(At, 1, 1); PG8_STAGE(PG8_SB(1, 0), b3, voffB); PG8_STAGE(PG8_SB(1, 1), b3 + hstep, voffB); PG8_STAGE(PG8_SA(1, 0), a3, x0);
            PG8_WAIT_V(8); PG8_WAIT_L(0); PG8_BAR; PG8_MMA(1, 0, At, B0); PG8_MMA(1, 1, At, B1); PG8_BAR; PG8_SCHED;
            } else {
            PG8_LDB(B0, 0, 0); PG8_SCHED; PG8_LDA(At, 0, 0); PG8_STAGE(PG8_SA(1, 1), a1, oc1);
            PG8_WAIT_L(8); PG8_BAR; PG8_WAIT_L(0); PG8_MMA(0, 0, At, B0); PG8_BAR; PG8_SCHED;
            PG8_LDB(B1, 0, 1); PG8_STAGE(PG8_SB(0, 0), b2, voffB);
            PG8_BAR; PG8_WAIT_L(0); PG8_MMA(0, 1, At, B1); PG8_BAR;
            PG8_LDA(At, 0, 1); PG8_STAGE(PG8_SA(0, 0), a2, x0);
            PG8_BAR; PG8_WAIT_L(0); PG8_MMA(1, 0, At, B0); PG8_BAR; PG8_SCHED;
            PG8_STAGE(PG8_SB(0, 1), b2 + hstep, voffB);
            PG8_WAIT_V(6); PG8_BAR; PG8_MMA(1, 1, At, B1); PG8_BAR;
            PG8_LDB(B0, 1, 0); PG8_SCHED; PG8_LDA(At, 1, 0); PG8_STAGE(PG8_SA(0, 1), a2, x1);
            PG8_WAIT_L(8); PG8_BAR; PG8_WAIT_L(0); PG8_MMA(0, 0, At, B0); PG8_BAR; PG8_SCHED;
            PG8_LDB(B1, 1, 1); PG8_STAGE(PG8_SB(1, 0), b3, voffB);
            PG8_BAR; PG8_WAIT_L(0); PG8_MMA(0, 1, At, B1); PG8_BAR;
            PG8_LDA(At, 1, 1); PG8_STAGE(PG8_SA(1, 0), a3, x0);
            PG8_BAR; PG8_WAIT_L(0); PG8_MMA(1, 0, At, B0); PG8_BAR; PG8_SCHED;
            PG8_STAGE(PG8_SB(1, 1), b3 + hstep, voffB);
            PG8_WAIT_V(6); PG8_BAR; PG8_MMA(1, 1, At, B1); PG8_BAR;
            }
        }
        if constexpr (ALIGN_EPI) { if (wr == 0) PG8_BAR; }
        if constexpr (!Epi::AFTER_DRAIN) { E(acc, cur, wr, wc, fr, fq); S.done(cur); }
        if (!has_next) break;
#pragma unroll
        for (int a = 0; a < 2; ++a)
#pragma unroll
            for (int b = 0; b < 2; ++b)
#pragma unroll
                for (int m = 0; m < 4; ++m)
#pragma unroll
                    for (int n = 0; n < 2; ++n) acc[a][b][m][n] = (f32x4){0.f, 0.f, 0.f, 0.f};
        cur = nxt; cA = nA; cB = nB; ++ui; oc0[0] = on0[0]; oc0[1] = on0[1]; oc1[0] = on1[0]; oc1[1] = on1[1];
        if constexpr (ALIGN_EPI) { if (wr == 1) PG8_BAR; }
    }
    PG8_WAIT_V(0);
    if constexpr (!ALIGN_EPI) { if (wr == 0) PG8_BAR; }
    PG8_BAR;
    if constexpr (Epi::AFTER_DRAIN) { E.fused(acc, cur, wr, wc, fr, fq, lds, wid, lane); S.done(cur); }
#undef PG8_OFFS
#undef PG8_SA
#undef PG8_SB
#undef PG8_STAGE
#undef PG8_LDA
#undef PG8_LDB
#undef PG8_MMA
#undef PG8_WAIT_V
#undef PG8_WAIT_L
#undef PG8_BAR
#undef PG8_SCHED
}
}
namespace mk {
#define LAS __attribute__((address_space(3)))
typedef unsigned short bf16;
typedef float f32x4 __attribute__((ext_vector_type(4)));
typedef unsigned u32x4 __attribute__((ext_vector_type(4)));
typedef unsigned u32x2 __attribute__((ext_vector_type(2)));
constexpr int NWAVES = 8, NTHR = 512;
constexpr int LDS_BYTES = 163840;
constexpr float C2 = 0.125f * 1.4426950408889634f;
constexpr int NPAD = 3584;
constexpr int C_QA = 0, C_KA = 512, C_VA = 1024, C_QI = 1536, C_KI = 1792, C_QB = 1856, C_FB = 2112, C_IB = 2368, C_GB = 2880, C_WI = 3392;

constexpr size_t N_CTL = 0;
constexpr size_t N_MOD = 1 * MiB;
constexpr size_t N_LB = 1 * MiB + 128 * 1024;
constexpr size_t N_ROPE = 2 * MiB;
constexpr size_t N_WTIN = 4 * MiB;
constexpr size_t N_WTOUT = 12 * MiB;
constexpr size_t N_HB = 16 * MiB;
constexpr size_t N_X1 = 48 * MiB;
constexpr size_t N_QA = 112 * MiB, N_KA = 128 * MiB, N_VA = 144 * MiB;
constexpr size_t N_QI = 160 * MiB;
constexpr size_t N_KI = 168 * MiB;
constexpr size_t N_WI = 170 * MiB;
constexpr size_t N_QB = 172 * MiB;
constexpr size_t N_FB = 180 * MiB;
constexpr size_t N_IB = 196 * MiB, N_GB = 212 * MiB;
constexpr size_t N_MASKT = 228 * MiB;
constexpr size_t N_MIX = 236 * MiB;
constexpr size_t N_SCORE = 268 * MiB;
constexpr size_t N_HG = 396 * MiB;
constexpr size_t N_W1T = 466 * MiB;
constexpr size_t N_W2T = 594 * MiB;
constexpr size_t N_END_A = 658 * MiB;

__device__ __forceinline__ unsigned f2bf(float f) { unsigned u = __builtin_bit_cast(unsigned, f); return (u + 0x7fffu + ((u >> 16) & 1u)) >> 16; }
__device__ __forceinline__ unsigned pk2(float lo, float hi) { unsigned r; asm volatile("v_cvt_pk_bf16_f32 %0, %1, %2" : "=v"(r) : "v"(lo), "v"(hi)); return r; }
__device__ __forceinline__ float bf2f(unsigned short b) { return __builtin_bit_cast(float, (unsigned)b << 16); }
__device__ __forceinline__ float wave_sum(float v) {
#pragma unroll
    for (int o = 1; o < 64; o <<= 1) v += __shfl_xor(v, o);
    return v;
}

struct Params {
    const float* in[18]; float* out; unsigned char* ws; unsigned long long* mask_old; unsigned long long prog; int nprog, pad;
};

struct EpiProj {
    static constexpr bool PERM = true, AFTER_DRAIN = false;
    unsigned char* ws;
    __device__ __forceinline__ void operator()(const pg8::f32x4 (&acc)[2][2][4][2], const pg8::Unit& u, int wr, int wc, int fr, int fq) const {
        const int row0 = u.pm * 256 + wr * 64 + fr;
        const float* rope = (const float*)(ws + N_ROPE);
#pragma unroll
        for (int bj = 0; bj < 2; ++bj) {
            const int c0 = u.pn * 256 + bj * 128 + wc * 32;
            bf16* dst = nullptr; float* fdst = nullptr; int ld = 0, cc = 0; bool rp = false; float scale = 1.f;
            if (c0 < C_KA) { dst = (bf16*)(ws + N_QA); ld = 512; cc = c0 - C_QA; rp = true; scale = C2; }
            else if (c0 < C_VA) { dst = (bf16*)(ws + N_KA); ld = 512; cc = c0 - C_KA; rp = true; }
            else if (c0 < C_QI) { dst = (bf16*)(ws + N_VA); ld = 512; cc = c0 - C_VA; }
            else if (c0 < C_KI) { dst = (bf16*)(ws + N_QI); ld = 256; cc = c0 - C_QI; rp = true; }
            else if (c0 < C_QB) { dst = (bf16*)(ws + N_KI); ld = 64; cc = c0 - C_KI; rp = true; }
            else if (c0 < C_FB) { dst = (bf16*)(ws + N_QB); ld = 256; cc = c0 - C_QB; }
            else if (c0 < C_IB) { fdst = (float*)(ws + N_FB); ld = 256; cc = c0 - C_FB; }
            else if (c0 < C_GB) { dst = (bf16*)(ws + N_IB); ld = 512; cc = c0 - C_IB; }
            else if (c0 < C_WI) { dst = (bf16*)(ws + N_GB); ld = 512; cc = c0 - C_GB; }
            else if (c0 == C_WI) {
                if (fq == 0) {
#pragma unroll
                    for (int ai = 0; ai < 2; ++ai)
#pragma unroll
                        for (int m = 0; m < 4; ++m) { const int row = row0 + ai * 128 + m * 16; const pg8::f32x4 v = acc[ai][bj][m][0] * 0.0625f; *(pg8::f32x4*)((float*)(ws + N_WI) + (size_t)row * 4) = v; }
                }
                continue;
            } else continue;
            rp = rp && ((cc & 32) == 0);
            const int col = cc + 8 * fq;
#pragma unroll
            for (int ai = 0; ai < 2; ++ai)
#pragma unroll
                for (int m = 0; m < 4; ++m) {
                    const int row = row0 + ai * 128 + m * 16;
                    pg8::f32x4 v0 = acc[ai][bj][m][0], v1 = acc[ai][bj][m][1];
                    if (rp) {
                        const pg8::f32x4 cs0 = *(const pg8::f32x4*)(rope + (size_t)row * 16), cs1 = *(const pg8::f32x4*)(rope + (size_t)row * 16 + 4);
                        const pg8::f32x4 sn0 = *(const pg8::f32x4*)(rope + (size_t)row * 16 + 8), sn1 = *(const pg8::f32x4*)(rope + (size_t)row * 16 + 12);
                        pg8::f32x4 o0, o1;
#pragma unroll
                        for (int j = 0; j < 4; ++j) { o0[j] = __shfl_xor(v0[j], 16); o1[j] = __shfl_xor(v1[j], 16); }
                        const float sg = (fq == 0) ? -1.f : 1.f;
                        if (fq < 2) { v0 = v0 * cs0 + o0 * sn0 * sg; v1 = v1 * cs1 + o1 * sn1 * sg; }
                    }
                    if (fdst) { float* p = fdst + (size_t)row * ld + col; *(pg8::f32x4*)p = v0; *(pg8::f32x4*)(p + 4) = v1; }
                    else {
                        v0 = v0 * scale; v1 = v1 * scale;
                        u32x4 w; w.x = pk2(v0[0], v0[1]); w.y = pk2(v0[2], v0[3]); w.z = pk2(v1[0], v1[1]); w.w = pk2(v1[2], v1[3]);
                        *(u32x4*)(dst + (size_t)row * ld + col) = w;
                    }
                }
        }
    }
};

struct TItem { const float* W; int ldw, scol0, nvalid; bf16* WT; size_t drow0; int kb; };
__device__ __forceinline__ void titem_issue(const TItem& it, int lane, float (&tv)[32]) {
    const int k0 = 64 * it.kb; const bool ok = (lane & 31) < it.nvalid;
#pragma unroll
    for (int i = 0; i < 32; ++i) { const int kk = 2 * i + (lane >> 5); tv[i] = __builtin_nontemporal_load(it.W + (size_t)(k0 + kk) * it.ldw + it.scol0 + (ok ? (lane & 31) : 0)); }
}
__device__ __forceinline__ void titem_finish(const TItem& it, int lane, const float (&tv)[32], LAS float* scr) {
    const int k0 = 64 * it.kb; const bool ok = (lane & 31) < it.nvalid;
#pragma unroll
    for (int i = 0; i < 32; ++i) { const int kk = 2 * i + (lane >> 5); scr[kk * 33 + (lane & 31)] = ok ? tv[i] : 0.f; }
    asm volatile("s_waitcnt lgkmcnt(0)" ::: "memory");
    const int c = lane & 7;
#pragma unroll
    for (int j = 0; j < 4; ++j) { const int n = (lane >> 3) + 8 * j; const LAS float* s = scr + (8 * c) * 33 + n;
        u32x4 o; o.x = pk2(s[0 * 33], s[1 * 33]); o.y = pk2(s[2 * 33], s[3 * 33]); o.z = pk2(s[4 * 33], s[5 * 33]); o.w = pk2(s[6 * 33], s[7 * 33]);
        __builtin_nontemporal_store(o, (u32x4*)(it.WT + (it.drow0 + n) * 1024 + k0 + 8 * c)); }
    asm volatile("s_waitcnt lgkmcnt(0)" ::: "memory");
}
#define TRANSPOSE_LOOP(first, stride, count, MK) do { \
    for (int r_ = (first); r_ < (count); r_ += 2 * (stride)) { \
        const bool two_ = r_ + (stride) < (count); \
        const TItem ia_ = MK(r_); const TItem ib_ = MK(two_ ? r_ + (stride) : r_); \
        float ta_[32], tb_[32]; \
        titem_issue(ia_, lane, ta_); if (two_) titem_issue(ib_, lane, tb_); \
        titem_finish(ia_, lane, ta_, scr); if (two_) titem_finish(ib_, lane, tb_, scr); } } while (0)

__device__ __forceinline__ void phase0(const Params& P, LAS unsigned char* lds, int vcu, int G, int wave, int lane) {
    unsigned char* ws = P.ws; const int tid = threadIdx.x;
    if (vcu < 96) {
        LAS float* sc = (LAS float*)lds;
        LAS float* red = (LAS float*)(lds + 16384);
        for (int i = tid; i < 4096; i += NTHR) { const float v = P.in[1][i]; sc[i] = v / (1.f + __expf(-v)); }
        __syncthreads();
        const int col = vcu * 64 + lane; const float* aw = P.in[3];
        float a0 = 0.f, a1 = 0.f, a2 = 0.f, a3 = 0.f;
        for (int k0 = wave * 128; k0 < wave * 128 + 128; k0 += 32) {
            float w[32];
#pragma unroll
            for (int i = 0; i < 32; ++i) w[i] = __builtin_nontemporal_load(aw + (size_t)(k0 + i) * 6144 + col);
#pragma unroll
            for (int i = 0; i < 32; ++i) { const int k = k0 + i; a0 += sc[k] * w[i]; a1 += sc[1024 + k] * w[i]; a2 += sc[2048 + k] * w[i]; a3 += sc[3072 + k] * w[i]; }
        }
        red[(wave * 4 + 0) * 64 + lane] = a0; red[(wave * 4 + 1) * 64 + lane] = a1; red[(wave * 4 + 2) * 64 + lane] = a2; red[(wave * 4 + 3) * 64 + lane] = a3;
        __syncthreads();
        if (wave < 4) { float s = 0.f;
#pragma unroll
            for (int w = 0; w < 8; ++w) s += red[(w * 4 + wave) * 64 + lane];
            ((float*)(ws + N_MOD))[wave * 6144 + col] = s + P.in[4][col]; }
        __syncthreads();
    }
    { for (int gi = vcu * NTHR + tid; gi < T * 8; gi += G * NTHR) { const int t = gi >> 3, i = gi & 7; const float invf = i == 0 ? 1.000000000e+00f : i == 1 ? 1.939227432e-01f : i == 2 ? 3.760603070e-02f : i == 3 ? 7.292664610e-03f : i == 4 ? 1.414213562e-03f : i == 5 ? 2.742481884e-04f : i == 6 ? 5.318295734e-05f : 1.031338525e-05f;     const float ang = (float)((const int*)P.in[2])[t] * invf;
          float* r = (float*)(ws + N_ROPE) + (size_t)t * 16; r[i] = (float)cos((double)ang); r[8 + i] = (float)sin((double)ang); }
      if (vcu == 255 && tid < 256) { const float l0 = P.in[8][tid], l1 = P.in[8][256 + tid]; const float m = fmaxf(l0, l1), e0 = __expf(l0 - m), e1 = __expf(l1 - m); ((float*)(ws + N_LB))[tid] = e0 / (e0 + e1); } }
    LAS float* scr = (LAS float*)(lds + 32768 + wave * 12288);
    const int gw = vcu * NWAVES + wave, NGW = G * NWAVES;
    constexpr int I_IN = 16 * 112, I_OUT = 16 * 32;
    auto mk_in = [&](int r) { const int kb = r / 112, ng = r % 112; int scol = 0, nv = 32;
        if (ng < 58) scol = 32 * ng; else if (ng < 106) scol = 32 * ng + 4; else if (ng == 106) { scol = 1856; nv = 4; } else nv = 0;
        return TItem{P.in[6], DIN, scol, nv, (bf16*)(ws + N_WTIN), (size_t)32 * ng, kb}; };
    auto mk_out = [&](int r) { const int kb = r / 32, ng = r % 32; return TItem{P.in[9], 1024, 32 * ng, 32, (bf16*)(ws + N_WTOUT), (size_t)32 * ng, kb}; };
    TRANSPOSE_LOOP(gw, NGW, I_IN, mk_in);
    TRANSPOSE_LOOP(gw, NGW, I_OUT, mk_out);
}
template <int PART>
__device__ __forceinline__ void transpose_moe(const Params& P, LAS unsigned char* lds, int vcu, int G, int wave, int lane) {
    unsigned char* ws = P.ws;
    LAS float* scr = (LAS float*)(lds + 32768 + wave * 12288);
    const int gw = vcu * NWAVES + wave, NGW = G * NWAVES;
    constexpr int I_W1 = 32 * 16 * 64, I_W2 = 32 * 16 * 32;
    if constexpr (PART == 0) {
        auto mk1 = [&](int r) { const int e = r >> 10, r2 = r & 1023, kb = r2 >> 6, ng = r2 & 63, pn = ng >> 3, within = ng & 7, half = within >> 2, off = (within & 3) * 32;
            return TItem{P.in[13] + (size_t)e * 1024 * 2048, 2048, half * 1024 + 128 * pn + off, 32, (bf16*)(ws + N_W1T), (size_t)e * 2048 + 32 * ng, kb}; };
        TRANSPOSE_LOOP(gw, NGW, I_W1, mk1);
    } else {
        auto mk2 = [&](int r) { const int e = r >> 9, r2 = r & 511, kb = r2 >> 5, ng = r2 & 31;
            return TItem{P.in[15] + (size_t)e * 1024 * 1024, 1024, 32 * ng, 32, (bf16*)(ws + N_W2T), (size_t)e * 1024 + 32 * ng, kb}; };
        TRANSPOSE_LOOP(gw, NGW, I_W2, mk2);
    }
}

__device__ __forceinline__ void phase1a(const Params& P, int vcu, int G, int wave, int lane) {
    const int gw = vcu * NWAVES + wave, NGW = G * NWAVES;
    const float* mod = (const float*)(P.ws + N_MOD);
    for (int r0 = gw * 8; r0 < T; r0 += NGW * 8) {
        const int b = r0 / S;
        f32x4 gs[4], sh[4];
#pragma unroll
        for (int j = 0; j < 4; ++j) { const f32x4 g = ((const f32x4*)P.in[5])[lane + 64 * j], sc = ((const f32x4*)(mod + b * 6144 + 1024))[lane + 64 * j]; gs[j] = g * (sc + 1.f); sh[j] = ((const f32x4*)(mod + b * 6144))[lane + 64 * j]; }
        for (int rr = 0; rr < 8; rr += 2) {
            const int row = r0 + rr;
            const f32x4* xr = (const f32x4*)(P.in[0] + (size_t)row * D) + lane;
            f32x4 v[4], w[4]; float ss = 0.f, st = 0.f;
#pragma unroll
            for (int j = 0; j < 4; ++j) { v[j] = xr[64 * j]; w[j] = xr[256 + 64 * j]; }
#pragma unroll
            for (int j = 0; j < 4; ++j) { ss += (v[j].x * v[j].x + v[j].y * v[j].y) + (v[j].z * v[j].z + v[j].w * v[j].w); st += (w[j].x * w[j].x + w[j].y * w[j].y) + (w[j].z * w[j].z + w[j].w * w[j].w); }
            const float rstd = rsqrtf(wave_sum(ss) * (1.f / D) + 1e-6f), rstd2 = rsqrtf(wave_sum(st) * (1.f / D) + 1e-6f);
            u32x2* o8 = (u32x2*)((bf16*)(P.ws + N_HB) + (size_t)row * D) + lane;
#pragma unroll
            for (int j = 0; j < 4; ++j) { const f32x4 o = v[j] * rstd * gs[j] + sh[j]; u32x2 q; q.x = pk2(o.x, o.y); q.y = pk2(o.z, o.w); o8[64 * j] = q;
                                          const f32x4 o2 = w[j] * rstd2 * gs[j] + sh[j]; u32x2 q2; q2.x = pk2(o2.x, o2.y); q2.y = pk2(o2.z, o2.w); o8[256 + 64 * j] = q2; }
        }
    }
}

}
namespace mk {
#define XB_TMO      128
#define XB_XCNT(j)  (256  + 64 * (j))
#define XB_XSUB(j)  (1280 + 64 * (j))
#define XB_XGEN(j)  (2304 + 64 * (j))
#define XB_TOP      3328
#define XB_TOPGEN   3392
#define XCD_BAR_WORDS 3456
#define XB_SPIN_CAP (1u << 18)

__device__ __forceinline__ unsigned xb_ld(unsigned* p)              { return __hip_atomic_load(p, __ATOMIC_RELAXED, __HIP_MEMORY_SCOPE_AGENT); }
__device__ __forceinline__ unsigned xb_add(unsigned* p, unsigned v) { return __hip_atomic_fetch_add(p, v, __ATOMIC_RELAXED, __HIP_MEMORY_SCOPE_AGENT); }
__device__ __forceinline__ unsigned xb_xcc_id() { return (unsigned)__builtin_amdgcn_s_getreg((3 << 11) | 20) & 0xFu; }
#define XB_SPIN(cond, bar) do { unsigned _sp = 0; while (cond) { __builtin_amdgcn_s_sleep(1); \
    if ((++_sp & 255u) == 0u) { if (xb_ld(&(bar)[XB_TMO])) break; if (_sp > XB_SPIN_CAP) { atomicAdd(&(bar)[XB_TMO], 1u); break; } } } } while (0)

struct XcdBarrier {
    unsigned* bar; unsigned x;
    volatile LAS unsigned* st;
};

__device__ __forceinline__ XcdBarrier xcd_barrier_post(unsigned* bar, volatile LAS unsigned* st) {
    XcdBarrier b; b.bar = bar; b.x = xb_xcc_id(); b.st = st;
    if (threadIdx.x == 0) (void)xb_add(&bar[XB_XCNT(b.x)], 1u);
    return b;
}
__device__ __forceinline__ void xcd_barrier_complete(unsigned* bar, unsigned x, unsigned& nloc, unsigned& nx) {
    const unsigned G = gridDim.x * gridDim.y * gridDim.z;
    unsigned sum, cnt, mine, sp = 0u;
    for (;;) {
        sum = 0u; cnt = 0u; mine = 0u;
#pragma unroll
        for (unsigned j = 0; j < 16; ++j) { const unsigned c = xb_ld(&bar[XB_XCNT(j)]); sum += c; cnt += (c > 0u) ? 1u : 0u; mine = (j == x) ? c : mine; }
        if (sum == G) break;
        __builtin_amdgcn_s_sleep(1);
        if ((++sp & 255u) == 0u) { if (xb_ld(&bar[XB_TMO])) break; if (sp > XB_SPIN_CAP) { atomicAdd(&bar[XB_TMO], 1u); break; } }
    }
    nloc = mine > 0u ? mine : 1u; nx = cnt > 0u ? cnt : 1u;
}

__device__ __forceinline__ void xcd_barrier(const XcdBarrier& b) {
    asm volatile("s_waitcnt vmcnt(0)" ::: "memory");
    __syncthreads();
    if (threadIdx.x == 0) {
        unsigned* bar = b.bar;
        __builtin_amdgcn_s_waitcnt(0);
        unsigned nloc = b.st[0], nx = b.st[1];
        if (nloc == 0u) { xcd_barrier_complete(bar, b.x, nloc, nx); b.st[0] = nloc; b.st[1] = nx; }
        const unsigned old = xb_add(&bar[XB_XSUB(b.x)], 1u);
        const unsigned gen = old / nloc;
        if (old + 1u == (gen + 1u) * nloc) {
            __builtin_amdgcn_fence(__ATOMIC_RELEASE, "agent");
            asm volatile("s_waitcnt vmcnt(0)" ::: "memory");
            const unsigned og = xb_add(&bar[XB_TOP], 1u);
            const unsigned tg = og / nx;
            if (og + 1u == (tg + 1u) * nx) xb_add(&bar[XB_TOPGEN], 1u);
            else XB_SPIN(xb_ld(&bar[XB_TOPGEN]) == tg, bar);
            __builtin_amdgcn_fence(__ATOMIC_ACQUIRE, "agent");
            xb_add(&bar[XB_XGEN(b.x)], 1u);
            asm volatile("s_waitcnt vmcnt(0)" ::: "memory");
        } else {
            XB_SPIN(xb_ld(&bar[XB_XGEN(b.x)]) == gen, bar);
            __builtin_amdgcn_fence(__ATOMIC_ACQUIRE, "agent");
            asm volatile("s_waitcnt vmcnt(0)" ::: "memory");
        }
    }
    __syncthreads();
}
}
namespace mk {
typedef short bf16x8 __attribute__((ext_vector_type(8)));
typedef float f32x16 __attribute__((ext_vector_type(16)));
typedef unsigned long long u64;
__device__ __forceinline__ int crow(int r, int hi) { return (r & 3) + 8 * (r >> 2) + 4 * hi; }

#define DPP_STEP(OP, v, ctrl, rmask) { const auto dpp_t_ = (decltype(v))__builtin_amdgcn_update_dpp((int)IDENT, (int)v, ctrl, rmask, 0xf, false); v = OP(v, dpp_t_); }
__device__ __forceinline__ int wave_sum_dpp(int v) {
    constexpr int IDENT = 0;
#define OPADD(a, b) ((a) + (b))
    DPP_STEP(OPADD, v, 0x111, 0xf); DPP_STEP(OPADD, v, 0x112, 0xf); DPP_STEP(OPADD, v, 0x114, 0xf); DPP_STEP(OPADD, v, 0x118, 0xf);
    DPP_STEP(OPADD, v, 0x142, 0xa); DPP_STEP(OPADD, v, 0x143, 0xc);
#undef OPADD
    return __builtin_amdgcn_readlane(v, 63);
}
__device__ __forceinline__ unsigned wave_min_dpp(unsigned v) {
    constexpr unsigned IDENT = 0xffffffffu;
#define OPMIN(a, b) __builtin_elementwise_min(a, b)
    DPP_STEP(OPMIN, v, 0x111, 0xf); DPP_STEP(OPMIN, v, 0x112, 0xf); DPP_STEP(OPMIN, v, 0x114, 0xf); DPP_STEP(OPMIN, v, 0x118, 0xf);
    DPP_STEP(OPMIN, v, 0x142, 0xa); DPP_STEP(OPMIN, v, 0x143, 0xc);
#undef OPMIN
    return (unsigned)__builtin_amdgcn_readlane((int)v, 63);
}
__device__ __forceinline__ unsigned wave_max_dpp(unsigned v) {
    constexpr unsigned IDENT = 0u;
#define OPMAX(a, b) __builtin_elementwise_max(a, b)
    DPP_STEP(OPMAX, v, 0x111, 0xf); DPP_STEP(OPMAX, v, 0x112, 0xf); DPP_STEP(OPMAX, v, 0x114, 0xf); DPP_STEP(OPMAX, v, 0x118, 0xf);
    DPP_STEP(OPMAX, v, 0x142, 0xa); DPP_STEP(OPMAX, v, 0x143, 0xc);
#undef OPMAX
    return (unsigned)__builtin_amdgcn_readlane((int)v, 63);
}
__device__ __forceinline__ void select_row(const float* srow, int nreg, int nwords, u64* mT, LAS unsigned* hist, int lane) {
    if (nreg <= 4) {
        for (int j = 0; j < nwords; ++j) if (lane == 0) { const u64 w = j < nreg ? ~0ull : 0ull; mT[(size_t)j * S] = w; }
        return;
    }
    unsigned key[64];
#pragma unroll
    for (int cq = 0; cq < 2; ++cq) {
        if (nreg > 32 * cq) {
            float f[32];
#pragma unroll
            for (int j = 0; j < 32; ++j) f[j] = __hip_atomic_load(srow + (32 * cq + j) * 64 + lane, __ATOMIC_RELAXED, __HIP_MEMORY_SCOPE_AGENT);
#pragma unroll
            for (int j = 0; j < 32; ++j) { const unsigned u = __float_as_uint(f[j] + 0.0f); const unsigned k = (u & 0x80000000u) ? ~u : (u | 0x80000000u); key[32 * cq + j] = (32 * cq + j < nreg) ? k : 0u; }
        } else {
#pragma unroll
            for (int j = 0; j < 32; ++j) key[32 * cq + j] = 0u;
        }
    }
#define TSTAGE(OFF, J, M) _Pragma("unroll") for (int k_ = 0; k_ < 32; ++k_) if (!(k_ & J)) { const unsigned a_ = key[OFF + k_], b_ = key[OFF + k_ + J]; \
        key[OFF + k_] = (a_ & M) | ((b_ << J) & ~M); key[OFF + k_ + J] = ((a_ >> J) & M) | (b_ & ~M); }
    TSTAGE(0, 16, 0x0000ffffu) TSTAGE(0, 8, 0x00ff00ffu) TSTAGE(0, 4, 0x0f0f0f0fu) TSTAGE(0, 2, 0x33333333u) TSTAGE(0, 1, 0x55555555u)
    if (nreg > 32) { TSTAGE(32, 16, 0x0000ffffu) TSTAGE(32, 8, 0x00ff00ffu) TSTAGE(32, 4, 0x0f0f0f0fu) TSTAGE(32, 2, 0x33333333u) TSTAGE(32, 1, 0x55555555u) }
#undef TSTAGE
    unsigned alive0 = nreg >= 32 ? 0xffffffffu : ((1u << nreg) - 1u), alive1 = nreg > 32 ? (nreg >= 64 ? 0xffffffffu : ((1u << (nreg - 32)) - 1u)) : 0u;
    unsigned G0 = 0u, G1 = 0u; int g = 0; bool done = false;
#pragma unroll
    for (int bq = 31; bq >= 0; --bq) if (!done) {
        const unsigned a10 = alive0 & key[bq], a11 = alive1 & key[32 + bq];
        const int tot = wave_sum_dpp(__builtin_popcount(a10) + __builtin_popcount(a11));
        if (g + tot == 256) { G0 |= a10; G1 |= a11; alive0 = 0u; alive1 = 0u; done = true; }
        else if (g + tot > 256) { alive0 = a10; alive1 = a11; }
        else { G0 |= a10; G1 |= a11; g += tot; alive0 &= ~key[bq]; alive1 &= ~key[32 + bq]; }
    }
    if (!done) {
        const int need = 256 - g; int before = 0; const u64 lt = (1ull << lane) - 1ull;
#pragma unroll
        for (int j = 0; j < 64; ++j) if (j < nreg) {
            const bool eq = (((j < 32 ? alive0 : alive1) >> (j & 31)) & 1u) != 0u; const u64 em = __ballot(eq);
            const int myrank = before + __popcll(em & lt);
            if (eq && myrank < need) { if (j < 32) G0 |= 1u << (j & 31); else G1 |= 1u << (j & 31); }
            before += __popcll(em);
        }
    }
    { auto rr = __builtin_amdgcn_permlane32_swap(G0, G1, false, false); G0 = rr[0]; G1 = rr[1]; }
#define XSTAGE(d, m) { const unsigned q0 = (unsigned)__builtin_amdgcn_ds_swizzle((int)G0, ((d) << 10) | 0x1f), q1 = (unsigned)__builtin_amdgcn_ds_swizzle((int)G1, ((d) << 10) | 0x1f); \
        if (lane & (d)) { G0 = ((q0 >> (d)) & (m)) | (G0 & ~(m)); G1 = ((q1 >> (d)) & (m)) | (G1 & ~(m)); } \
        else { G0 = (G0 & (m)) | ((q0 << (d)) & ~(m)); G1 = (G1 & (m)) | ((q1 << (d)) & ~(m)); } }
    XSTAGE(16, 0x0000ffffu) XSTAGE(8, 0x00ff00ffu) XSTAGE(4, 0x0f0f0f0fu) XSTAGE(2, 0x33333333u) XSTAGE(1, 0x55555555u)
#undef XSTAGE
    if (lane < nwords) mT[(size_t)lane * S] = ((u64)G1 << 32) | G0;
}

__device__ __forceinline__ void phase_index(const Params& P, LAS unsigned char* lds, int vcu, int G, int wave, int lane, u64* mask_old) {
    unsigned char* ws = P.ws; const int tid = threadIdx.x, r32 = lane & 31, hi = lane >> 5;
    const bf16* QI = (const bf16*)(ws + N_QI); const bf16* KI = (const bf16*)(ws + N_KI); const float* WI = (const float*)(ws + N_WI);
    float* scb = (float*)(ws + N_SCORE) + (size_t)blockIdx.x * (32 * 4096);
    LAS float* wl = (LAS float*)lds;
    for (int pr = vcu; pr < 256; pr += G) {
        const int b = pr >> 6, p = pr & 63;
        for (int half = 0; half < 2; ++half) {
            const int g = half ? 127 - p : p;
            const int tl0 = 32 * g, nreg = g / 2 + 1, nwords = 4 * (tl0 / 256 + 1);
            const size_t t0 = (size_t)b * S + tl0;
            __syncthreads();
            if (nreg > 4) {
                if (tid < 128) wl[tid] = WI[t0 * 4 + tid];
                bf16x8 aq[4][4];
#pragma unroll
                for (int h = 0; h < 4; ++h)
#pragma unroll
                    for (int d0 = 0; d0 < 4; ++d0) aq[h][d0] = *(const bf16x8*)(QI + (t0 + r32) * 256 + h * 64 + d0 * 16 + hi * 8);
                __syncthreads();
                bf16x8 bkn[4];
#pragma unroll
                for (int d0 = 0; d0 < 4; ++d0) bkn[d0] = *(const bf16x8*)(KI + ((size_t)b * S + 32 * wave + r32) * 64 + d0 * 16 + hi * 8);
                for (int kt = wave; kt < 2 * nreg; kt += NWAVES) {
                    bf16x8 bk[4];
#pragma unroll
                    for (int d0 = 0; d0 < 4; ++d0) bk[d0] = bkn[d0];
                    if (kt + NWAVES < 2 * nreg) {
#pragma unroll
                        for (int d0 = 0; d0 < 4; ++d0) bkn[d0] = *(const bf16x8*)(KI + ((size_t)b * S + 32 * (kt + NWAVES) + r32) * 64 + d0 * 16 + hi * 8);
                    }
                    f32x16 sc = {};
#pragma unroll
                    for (int h = 0; h < 4; ++h) {
                        f32x16 a = {};
#pragma unroll
                        for (int d0 = 0; d0 < 4; ++d0) a = __builtin_amdgcn_mfma_f32_32x32x16_bf16(aq[h][d0], bk[d0], a, 0, 0, 0);
#pragma unroll
                        for (int r = 0; r < 16; ++r) sc[r] += wl[crow(r, hi) * 4 + h] * fmaxf(a[r], 0.f);
                        asm volatile("" : "+v"(sc));
                    }
#pragma unroll
                    for (int r = 0; r < 16; ++r) scb[crow(r, hi) * 4096 + 32 * kt + r32] = sc[r];
                }
                asm volatile("s_waitcnt vmcnt(0)" ::: "memory");
                __syncthreads();
            }
            for (int qq = 0; qq < 4; ++qq) {
                const int q = wave * 4 + qq; const int tl = tl0 + q;
                select_row(scb + q * 4096, nreg, nwords, (u64*)(ws + N_MASKT) + (size_t)b * 64 * S + tl, (LAS unsigned*)(lds + 1024) + wave * 256, lane);
            }
        }
    }
}
}
namespace mk {
typedef short s16x4 __attribute__((ext_vector_type(4)));
constexpr int AT_PITCH = 512;
constexpr int AT_SLOT = 18432, AT_K = 0, AT_V = 8192, AT_M = 16384, AT_WS = 3 * AT_SLOT, AT_OST = AT_WS + 8 * 512;
__device__ __forceinline__ void glds16(const void* gsrc, unsigned lds_dst) { unsigned keep;
    asm volatile("s_mov_b32 %0, m0\n\ts_mov_b32 m0, %2\n\ts_nop 0\n\tglobal_load_lds_dwordx4 %1, off\n\ts_mov_b32 m0, %0" : "=&s"(keep) : "v"(gsrc), "s"(lds_dst) : "memory"); }
__device__ __forceinline__ void glds4(const void* gsrc, unsigned lds_dst) { unsigned keep;
    asm volatile("s_mov_b32 %0, m0\n\ts_mov_b32 m0, %2\n\ts_nop 0\n\tglobal_load_lds_dword %1, off\n\ts_mov_b32 m0, %0" : "=&s"(keep) : "v"(gsrc), "s"(lds_dst) : "memory"); }
__device__ __forceinline__ float xhalf(float v) { return __shfl_xor(v, 32); }

__device__ __forceinline__ void attn_unit(const Params& P, LAS unsigned char* lds, int b, int h, int qb, int wave, int lane) {
    unsigned char* ws = P.ws; const int r32 = lane & 31, hi = lane >> 5;
    const bf16* QA = (const bf16*)(ws + N_QA); const bf16* KA = (const bf16*)(ws + N_KA); const bf16* VA = (const bf16*)(ws + N_VA);
    const u64* MT = (const u64*)(ws + N_MASKT) + (size_t)b * 64 * S;
    const size_t rowbase = (size_t)b * S; const int q0 = qb * 256, tq = q0 + wave * 32 + r32;
    const bf16* Kh = KA + rowbase * AT_PITCH + h * 64; const bf16* Vh = VA + rowbase * AT_PITCH + h * 64;
    const unsigned lds0 = (unsigned)(uintptr_t)lds;
    LAS float* wsf = (LAS float*)(lds + AT_WS) + wave * 128;
    const bf16* ksrc = Kh + (size_t)lane * AT_PITCH + wave * 8;
    const bf16* vsrc = Vh + (size_t)(16 * (wave & 3) + (lane >> 2)) * AT_PITCH + (wave >> 2) * 32 + (lane & 3) * 8;
    const unsigned kdst = lds0 + AT_K + wave * 1024, vdst = lds0 + AT_V + wave * 1024, mdst = lds0 + AT_M + wave * 256;
    const unsigned char* msrc = (const unsigned char*)(MT + q0) + wave * 256 + lane * 4;
    const int NT = 4 * (qb + 1);
    bf16x8 qr[4];
#pragma unroll
    for (int d0 = 0; d0 < 4; ++d0) qr[d0] = *(const bf16x8*)(QA + (rowbase + tq) * AT_PITCH + h * 64 + d0 * 16 + hi * 8);
    float m = -INFINITY, l = 0.f; f32x16 o[2]; o[0] = f32x16{}; o[1] = f32x16{};
#define AT_ISSUE(tt, so) do { glds16(ksrc + (size_t)(tt) * 64 * AT_PITCH, (unsigned)__builtin_amdgcn_readfirstlane(kdst + (so))); \
                              glds16(vsrc + (size_t)(tt) * 64 * AT_PITCH, (unsigned)__builtin_amdgcn_readfirstlane(vdst + (so))); \
                              glds4(msrc + (size_t)(tt) * S * 8, (unsigned)__builtin_amdgcn_readfirstlane(mdst + (so))); } while (0)
    AT_ISSUE(0, 0); AT_ISSUE(1, AT_SLOT);
#define AT_QK(P0, P1, so) do { const LAS unsigned char* kb_ = lds + (so) + AT_K + hi * 1024 + r32 * 16; P0 = f32x16{}; P1 = f32x16{}; \
        _Pragma("unroll") for (int d0 = 0; d0 < 4; ++d0) { \
            const bf16x8 b0_ = *(const LAS bf16x8*)(kb_ + d0 * 2048), b1_ = *(const LAS bf16x8*)(kb_ + d0 * 2048 + 512); \
            P0 = __builtin_amdgcn_mfma_f32_32x32x16_bf16(b0_, qr[d0], P0, 0, 0, 0); P1 = __builtin_amdgcn_mfma_f32_32x32x16_bf16(b1_, qr[d0], P1, 0, 0, 0); } } while (0)
    int slot = 0, slot1 = AT_SLOT, slot2 = 2 * AT_SLOT;
    asm volatile("s_waitcnt vmcnt(3)\n\ts_barrier" ::: "memory");
    f32x16 p0n, p1n;
    AT_QK(p0n, p1n, 0);
    for (int t = 0; t < NT; ++t) {
        f32x16 p0 = p0n, p1 = p1n;
        if (t + 1 < NT) asm volatile("s_waitcnt vmcnt(0)\n\ts_barrier" ::: "memory");
        if (t + 2 < NT) AT_ISSUE(t + 2, slot2);
        if (t + 1 < NT) AT_QK(p0n, p1n, slot1);
        const u64 mw = *(const LAS u64*)(lds + slot + AT_M + (wave * 32 + r32) * 8);
        const int lo = (int)((unsigned)mw >> (4 * hi)), hw = (int)((unsigned)(mw >> 32) >> (4 * hi));
        float rm, rm2;
        asm("v_max3_f32 %0, %1, %2, %3" : "=v"(rm) : "v"(p0[0]), "v"(p0[1]), "v"(p1[0]));
        asm("v_max3_f32 %0, %1, %2, %3" : "=v"(rm2) : "v"(p0[2]), "v"(p0[3]), "v"(p1[1]));
        asm("v_max3_f32 %0, %1, %2, %3" : "=v"(rm) : "v"(rm), "v"(p1[2]), "v"(p1[3]));
#pragma unroll
        for (int r = 4; r < 16; r += 4) {
            asm("v_max3_f32 %0, %1, %2, %3" : "=v"(rm) : "v"(rm), "v"(p0[r]), "v"(p0[r + 1]));
            asm("v_max3_f32 %0, %1, %2, %3" : "=v"(rm2) : "v"(rm2), "v"(p0[r + 2]), "v"(p0[r + 3]));
            asm("v_max3_f32 %0, %1, %2, %3" : "=v"(rm) : "v"(rm), "v"(p1[r]), "v"(p1[r + 1]));
            asm("v_max3_f32 %0, %1, %2, %3" : "=v"(rm2) : "v"(rm2), "v"(p1[r + 2]), "v"(p1[r + 3]));
        }
        rm = fmaxf(rm, rm2);
        { auto rr = __builtin_amdgcn_permlane32_swap(__float_as_uint(rm), __float_as_uint(rm), false, false); rm = fmaxf(__uint_as_float(rr[0]), __uint_as_float(rr[1])); }
        const float mn = fmaxf(m, rm);
        const float alpha = __builtin_amdgcn_exp2f(m - mn);
        if (__any(mn > m)) {
            if (hi == 0) wsf[r32] = alpha;
            asm volatile("s_waitcnt lgkmcnt(0)" ::: "memory");
#pragma unroll
            for (int r = 0; r < 16; ++r) { const float a = wsf[crow(r, hi)]; o[0][r] *= a; o[1][r] *= a; }
            l *= alpha;
        }
        m = mn;
        float sacc = 0.f;
#pragma unroll
        for (int r = 0; r < 16; ++r) { const int cb = (r & 3) + 8 * (r >> 2);
            p0[r] = __builtin_bit_cast(float, __builtin_bit_cast(int, __builtin_amdgcn_exp2f(p0[r] - mn)) & __builtin_amdgcn_sbfe(lo, cb, 1));
            p1[r] = __builtin_bit_cast(float, __builtin_bit_cast(int, __builtin_amdgcn_exp2f(p1[r] - mn)) & __builtin_amdgcn_sbfe(hw, cb, 1));
            sacc += p0[r] + p1[r]; }
        l += sacc;
        u32x4 pw0, pw1, pw2, pw3;
        pw0 = (u32x4){pk2(p0[0], p0[1]), pk2(p0[2], p0[3]), pk2(p0[4], p0[5]), pk2(p0[6], p0[7])};
        pw1 = (u32x4){pk2(p0[8], p0[9]), pk2(p0[10], p0[11]), pk2(p0[12], p0[13]), pk2(p0[14], p0[15])};
        pw2 = (u32x4){pk2(p1[0], p1[1]), pk2(p1[2], p1[3]), pk2(p1[4], p1[5]), pk2(p1[6], p1[7])};
        pw3 = (u32x4){pk2(p1[8], p1[9]), pk2(p1[10], p1[11]), pk2(p1[12], p1[13]), pk2(p1[14], p1[15])};
        { const int vb = (int)(lds0 + slot + AT_V) + ((lane >> 4) & 1) * 32 + (lane & 3) * 8 + (4 * hi + ((lane & 15) >> 2)) * 64;
#pragma unroll
          for (int d0 = 0; d0 < 2; ++d0) { s16x4 vl[4], vh[4];
#pragma unroll
              for (int ks = 0; ks < 4; ++ks) {
                  asm volatile("ds_read_b64_tr_b16 %0,%1 offset:%c2" : "=&v"(vl[ks]) : "v"(vb), "i"(d0 * 4096 + ks * 1024) : "memory");
                  asm volatile("ds_read_b64_tr_b16 %0,%1 offset:%c2" : "=&v"(vh[ks]) : "v"(vb), "i"(d0 * 4096 + ks * 1024 + 512) : "memory"); }
              asm volatile("s_waitcnt lgkmcnt(0)" ::: "memory"); __builtin_amdgcn_sched_barrier(0);
#define PKV(k) (bf16x8){vl[k][0], vl[k][1], vl[k][2], vl[k][3], vh[k][0], vh[k][1], vh[k][2], vh[k][3]}
              o[d0] = __builtin_amdgcn_mfma_f32_32x32x16_bf16(__builtin_bit_cast(bf16x8, pw0), PKV(0), o[d0], 0, 0, 0);
              o[d0] = __builtin_amdgcn_mfma_f32_32x32x16_bf16(__builtin_bit_cast(bf16x8, pw1), PKV(1), o[d0], 0, 0, 0);
              o[d0] = __builtin_amdgcn_mfma_f32_32x32x16_bf16(__builtin_bit_cast(bf16x8, pw2), PKV(2), o[d0], 0, 0, 0);
              o[d0] = __builtin_amdgcn_mfma_f32_32x32x16_bf16(__builtin_bit_cast(bf16x8, pw3), PKV(3), o[d0], 0, 0, 0);
#undef PKV
          } }
        { const int s_ = slot; slot = slot1; slot1 = slot2; slot2 = s_; }
    }
#undef AT_ISSUE
#undef AT_QK
    l += xhalf(l);
    if (hi == 0) wsf[32 + r32] = l;
    asm volatile("s_waitcnt lgkmcnt(0)" ::: "memory");
    { bf16* stg = (bf16*)((unsigned char*)nullptr); (void)stg; }
    LAS bf16* stg = (LAS bf16*)(lds + AT_OST) + wave * 2048;
#pragma unroll
    for (int r = 0; r < 16; ++r) { const int orow = crow(r, hi); const float rl = __builtin_amdgcn_rcpf(wsf[32 + orow]);
#pragma unroll
        for (int d0 = 0; d0 < 2; ++d0) stg[orow * 64 + d0 * 32 + r32] = (bf16)f2bf(o[d0][r] * rl); }
    asm volatile("s_waitcnt lgkmcnt(0)" ::: "memory");
    bf16* Ow = (bf16*)(ws + N_MIX) + (rowbase + q0 + wave * 32) * 1024 + h * 64;
#pragma unroll
    for (int i = 0; i < 4; ++i) { const int row = i * 8 + (lane >> 3), ch = lane & 7; const u32x4 v = *(const LAS u32x4*)(stg + row * 64 + ch * 8); *(u32x4*)(Ow + (size_t)row * 1024 + ch * 8) = v; }
    asm volatile("s_waitcnt lgkmcnt(0)" ::: "memory");
    __syncthreads();
}

__device__ __forceinline__ void phase_attn(const Params& P, LAS unsigned char* lds, int vcu, int G, int wave, int lane) {
    for (int pr = vcu; pr < 256; pr += G) {
        const int bh = pr >> 3, s = pr & 7, first = (pr & 8) ? 15 - s : s;
        attn_unit(P, lds, bh >> 3, bh & 7, first, wave, lane);
        if (pr < G) { transpose_moe<0>(P, lds, vcu, G, wave, lane); transpose_moe<1>(P, lds, vcu, G, wave, lane); __syncthreads(); }
        attn_unit(P, lds, bh >> 3, bh & 7, 15 - first, wave, lane);
    }
}
}
namespace mk {
constexpr size_t N_BCNT = 64 * 1024;
constexpr size_t N_TOK = 1 * MiB + 256 * 1024;
constexpr size_t N_ROWOF = 3 * MiB, N_RANK = 3 * MiB + 256 * 1024, N_GATE = 3 * MiB + 512 * 1024, N_TOPE = 3 * MiB + 768 * 1024;
constexpr size_t N_XS = 112 * MiB;
constexpr size_t N_ACT = 256 * MiB;
constexpr size_t N_Y = 658 * MiB;
constexpr size_t N_END_E = 802 * MiB;
constexpr int LDS_MISC = 131072;

struct EpiX1 {
    static constexpr bool PERM = false, AFTER_DRAIN = false;
    const float* x; const float* mod; float* x1;
    __device__ __forceinline__ void operator()(const pg8::f32x4 (&acc)[2][2][4][2], const pg8::Unit& u, int wr, int wc, int fr, int fq) const {
        const int row0 = u.pm * 256 + wr * 64 + fr, b = u.pm >> 4, col0 = u.pn * 256 + wc * 32 + 4 * fq;
#pragma unroll
        for (int bj = 0; bj < 2; ++bj)
#pragma unroll
            for (int n = 0; n < 2; ++n) {
                const int c = col0 + bj * 128 + n * 16;
                const pg8::f32x4 g = *(const pg8::f32x4*)(mod + b * 6144 + 2048 + c);
#pragma unroll
                for (int ai = 0; ai < 2; ++ai)
#pragma unroll
                    for (int m = 0; m < 4; ++m) { const size_t off = (size_t)(row0 + ai * 128 + m * 16) * 1024 + c;
                        *(pg8::f32x4*)(x1 + off) = *(const pg8::f32x4*)(x + off) + g * acc[ai][bj][m][n]; }
            }
    }
};
struct EpiSwiglu {
    static constexpr bool PERM = true, AFTER_DRAIN = false;
    const float* b1; bf16* act;
    __device__ __forceinline__ void operator()(const pg8::f32x4 (&acc)[2][2][4][2], const pg8::Unit& u, int wr, int wc, int fr, int fq) const {
        const int e = u.pn >> 3, pnl = u.pn & 7, row0 = u.pm * 256 + wr * 64 + fr, colg = pnl * 128 + wc * 32 + 8 * fq;
        const float* bg = b1 + (size_t)e * 2048 + colg;
        const pg8::f32x4 bg0 = *(const pg8::f32x4*)bg, bg1 = *(const pg8::f32x4*)(bg + 4), bl0 = *(const pg8::f32x4*)(bg + 1024), bl1 = *(const pg8::f32x4*)(bg + 1028);
#pragma unroll
        for (int ai = 0; ai < 2; ++ai)
#pragma unroll
            for (int m = 0; m < 4; ++m) {
                const int row = row0 + ai * 128 + m * 16;
                const pg8::f32x4 g0 = acc[ai][0][m][0] + bg0, g1 = acc[ai][0][m][1] + bg1, l0 = acc[ai][1][m][0] + bl0, l1 = acc[ai][1][m][1] + bl1;
                float o[8];
#pragma unroll
                for (int j = 0; j < 8; ++j) { float g = j < 4 ? g0[j] : g1[j - 4], l = j < 4 ? l0[j] : l1[j - 4];
                    g = fminf(g, 7.f); l = fminf(fmaxf(l, -7.f), 7.f);
                    o[j] = g * __builtin_amdgcn_rcpf(1.f + __expf(-1.702f * g)) * (l + 1.f); }
                u32x4 w; w.x = pk2(o[0], o[1]); w.y = pk2(o[2], o[3]); w.z = pk2(o[4], o[5]); w.w = pk2(o[6], o[7]);
                *(u32x4*)(act + (size_t)row * 1024 + colg) = w;
            }
    }
};
struct EpiY {
    static constexpr bool PERM = true, AFTER_DRAIN = false;
    const float* b2; bf16* y;
    __device__ __forceinline__ void operator()(const pg8::f32x4 (&acc)[2][2][4][2], const pg8::Unit& u, int wr, int wc, int fr, int fq) const {
        const int e = u.pn >> 2, pnl = u.pn & 3, row0 = u.pm * 256 + wr * 64 + fr;
#pragma unroll
        for (int bj = 0; bj < 2; ++bj) {
            const int col = pnl * 256 + bj * 128 + wc * 32 + 8 * fq;
            const pg8::f32x4 b0 = *(const pg8::f32x4*)(b2 + (size_t)e * 1024 + col), bb1 = *(const pg8::f32x4*)(b2 + (size_t)e * 1024 + col + 4);
#pragma unroll
            for (int ai = 0; ai < 2; ++ai)
#pragma unroll
                for (int m = 0; m < 4; ++m) {
                    const pg8::f32x4 v0 = acc[ai][bj][m][0] + b0, v1 = acc[ai][bj][m][1] + bb1;
                    u32x4 w; w.x = pk2(v0[0], v0[1]); w.y = pk2(v0[2], v0[3]); w.z = pk2(v1[0], v1[1]); w.w = pk2(v1[2], v1[3]);
                    *(u32x4*)(y + (size_t)(row0 + ai * 128 + m * 16) * 1024 + col) = w;
                }
        }
    }
};
template <int NPN, bool GATHER_>
struct MoeOrder {
    static constexpr bool GATHER = GATHER_;
    const LAS int* blke; int nunits, G, c; const int* tok;
    __device__ __forceinline__ bool next(int i, pg8::Unit& u) const {
        const int L = i * G + c; if (L >= nunits) return false;
        const int rb = L / NPN, pn = L % NPN; u.pm = rb; u.pn = blke[rb] * NPN + pn; return true;
    }
    __device__ __forceinline__ void a_ready(const pg8::Unit&) const {}
    __device__ __forceinline__ void done(const pg8::Unit&) const {}
};
__device__ __forceinline__ int moe_tables(const int* cnt, LAS int* ps, LAS int* blke) {
    __syncthreads();
    if (threadIdx.x == 0) { int a = 0; for (int e = 0; e < 32; ++e) { ps[e] = a; a += (__hip_atomic_load(cnt + e, __ATOMIC_RELAXED, __HIP_MEMORY_SCOPE_AGENT) + 255) / 256 * 256; } ps[32] = a; }
    __syncthreads();
    const int nrb = ps[32] >> 8;
    for (int i = threadIdx.x; i < nrb; i += NTHR) { int e = 0; while (e < 31 && i * 256 >= ps[e + 1]) ++e; blke[i] = e; }
    __syncthreads();
    return nrb;
}

__device__ __forceinline__ void phase_route(const Params& P, LAS unsigned char* lds, int vcu, int G, int wave, int lane) {
    unsigned char* ws = P.ws; const int tid = threadIdx.x;
    LAS float* rwl = (LAS float*)lds;
    LAS int* lcnt = (LAS int*)(lds + 147456);
    for (int idx = tid; idx < 8192; idx += NTHR) *(LAS f32x4*)(rwl + (idx >> 3) * 36 + (idx & 7) * 4) = ((const f32x4*)P.in[11])[idx];
    if (tid < 32) lcnt[tid] = 0;
    __syncthreads();
    const float* mod = (const float*)(ws + N_MOD); const float* X1 = (const float*)(ws + N_X1);
    const int gw = vcu * NWAVES + wave, NGW = G * NWAVES;
    const float rbias = P.in[12][lane >> 1];
    for (int r0 = gw * 2; r0 < T; r0 += NGW * 2) {
        const int b = r0 / S;
        float hv[2][16];
        {
            float v[2][16], ss0 = 0.f, ss1 = 0.f;
#pragma unroll
            for (int m = 0; m < 16; ++m) { v[0][m] = X1[(size_t)r0 * D + lane + 64 * m]; v[1][m] = X1[(size_t)(r0 + 1) * D + lane + 64 * m]; ss0 += v[0][m] * v[0][m]; ss1 += v[1][m] * v[1][m]; }
            const float rs0 = rsqrtf(wave_sum(ss0) * (1.f / D) + 1e-6f), rs1 = rsqrtf(wave_sum(ss1) * (1.f / D) + 1e-6f);
#pragma unroll
            for (int m = 0; m < 16; ++m) { const int k = lane + 64 * m; const float gs = P.in[10][k] * (1.f + mod[b * 6144 + 4096 + k]), sh = mod[b * 6144 + 3072 + k];
                hv[0][m] = v[0][m] * rs0 * gs + sh; hv[1][m] = v[1][m] * rs1 * gs + sh;
                ((bf16*)(ws + N_HB))[(size_t)r0 * D + k] = (bf16)f2bf(hv[0][m]); ((bf16*)(ws + N_HB))[(size_t)(r0 + 1) * D + k] = (bf16)f2bf(hv[1][m]); }
        }
        float a0[32], a1[32];
        {
            typedef float f32x2p __attribute__((ext_vector_type(2)));
            f32x2p ac[32];
#pragma unroll
            for (int e = 0; e < 32; ++e) ac[e] = (f32x2p){0.f, 0.f};
#pragma unroll
            for (int m = 0; m < 16; ++m) {
                const LAS float* wr_ = rwl + (lane + 64 * m) * 36; const f32x2p h2 = {hv[0][m], hv[1][m]};
#pragma unroll
                for (int i = 0; i < 8; ++i) { const f32x4 w = *(const LAS f32x4*)(wr_ + 4 * i);
#pragma unroll
                    for (int c = 0; c < 4; ++c) ac[4 * i + c] = __builtin_elementwise_fma(h2, (f32x2p){w[c], w[c]}, ac[4 * i + c]); }
            }
#pragma unroll
            for (int e = 0; e < 32; ++e) { a0[e] = ac[e].x; a1[e] = ac[e].y; }
        }
#define TRED(W, N) { const bool up = (lane & W) != 0; _Pragma("unroll") for (int e = 0; e < N; ++e) { \
            const float k0 = up ? a0[e + N] : a0[e], s0 = up ? a0[e] : a0[e + N]; a0[e] = k0 + __shfl_xor(s0, W); \
            const float k1 = up ? a1[e + N] : a1[e], s1 = up ? a1[e] : a1[e + N]; a1[e] = k1 + __shfl_xor(s1, W); } }
        TRED(32, 16) TRED(16, 8) TRED(8, 4) TRED(4, 2) TRED(2, 1)
#undef TRED
        a0[0] += __shfl_xor(a0[0], 1); a1[0] += __shfl_xor(a1[0], 1);
#pragma unroll
        for (int r = 0; r < 2; ++r) {
            const float logit = (r ? a1[0] : a0[0]) + rbias; const int e = lane >> 1;
            const unsigned u = __float_as_uint(logit + 0.0f); const unsigned mono = (u & 0x80000000u) ? ~u : (u | 0x80000000u);
            unsigned key = mono;
            float tv[4]; int te[4];
#pragma unroll
            for (int k = 0; k < 4; ++k) {
                const unsigned mx = wave_max_dpp(key);
                const int L = __ffsll((long long)__ballot(key == mx)) - 1;
                te[k] = L >> 1; tv[k] = __builtin_bit_cast(float, __builtin_amdgcn_readlane(__builtin_bit_cast(int, logit), L));
                if (e == te[k]) key = 0u;
            }
            const float p1 = __expf(tv[1] - tv[0]), p2 = __expf(tv[2] - tv[0]), p3 = __expf(tv[3] - tv[0]); const float inv = 1.f / (1.f + p1 + p2 + p3);
            if (lane < 4) { const int t = r0 + r; const int ee = lane == 0 ? te[0] : lane == 1 ? te[1] : lane == 2 ? te[2] : te[3]; const float gg = (lane == 0 ? 1.f : lane == 1 ? p1 : lane == 2 ? p2 : p3) * inv;
                ((int*)(ws + N_TOPE))[t * 4 + lane] = ee; ((float*)(ws + N_GATE))[t * 4 + lane] = gg; ((int*)(ws + N_RANK))[t * 4 + lane] = (vcu << 16) | __hip_atomic_fetch_add(lcnt + ee, 1, __ATOMIC_RELAXED, __HIP_MEMORY_SCOPE_WORKGROUP); }
        }
    }
    __syncthreads();
    if (tid < 32) ((int*)(ws + N_BCNT))[vcu * 32 + tid] = lcnt[tid];
}
__device__ __forceinline__ void phase_scatter(const Params& P, LAS unsigned char* lds, int vcu, int G, int wave, int lane) {
    unsigned char* ws = P.ws; const int tid = threadIdx.x;
    LAS int* ps = (LAS int*)(lds + LDS_MISC); LAS int* base = (LAS int*)lds;
    const int* bc = (const int*)(ws + N_BCNT);
    __syncthreads();
    for (int i = tid; i < G * 32; i += NTHR) base[i] = bc[i];
    __syncthreads();
    if (tid < 32) { int a = 0; for (int k = 0; k < G; ++k) { const int v = base[k * 32 + tid]; base[k * 32 + tid] = a; a += v; } ps[40 + tid] = a; }
    __syncthreads();
    if (tid == 0) { int a = 0; for (int e = 0; e < 32; ++e) { ps[e] = a; a += (ps[40 + e] + 255) / 256 * 256; } ps[32] = a; }
    __syncthreads();
    if (blockIdx.x == 0 && tid < 32) ((int*)(ws + N_CTL))[tid] = ps[40 + tid];
    const int gw = vcu * NWAVES + wave, NGW = G * NWAVES;
    int* tok = (int*)(ws + N_TOK);
    for (int i = vcu * NTHR + tid; i < T * 4; i += G * NTHR) {
        const int e = ((const int*)(ws + N_TOPE))[i], rk = ((const int*)(ws + N_RANK))[i];
        const int row = ps[e] + base[(rk >> 16) * 32 + e] + (rk & 0xffff);
        ((int*)(ws + N_ROWOF))[i] = row; tok[row] = i >> 2;
    }
    for (int e = vcu; e < 32; e += G) { const int r0 = ps[e] + ps[40 + e], r1 = ps[e + 1]; for (int r = r0 + tid; r < r1; r += NTHR) tok[r] = 0; }
}
__device__ __forceinline__ void final_pair(const Params& P, const float* mod, int t, int lane) {
    unsigned char* ws = P.ws; const int b = t / S;
    f32x4 acc[2][4]; u32x2 yv[2][4][4]; float gk[2][4];
#pragma unroll
    for (int r = 0; r < 2; ++r)
#pragma unroll
        for (int k = 0; k < 4; ++k) {
            gk[r][k] = ((const float*)(ws + N_GATE))[(t + r) * 4 + k]; const int row = ((const int*)(ws + N_ROWOF))[(t + r) * 4 + k];
            const u32x2* yr = (const u32x2*)((const bf16*)(ws + N_Y) + (size_t)row * D) + lane;
#pragma unroll
            for (int j = 0; j < 4; ++j) yv[r][k][j] = yr[64 * j];
        }
    f32x4 xv[2][4];
#pragma unroll
    for (int r = 0; r < 2; ++r)
#pragma unroll
        for (int j = 0; j < 4; ++j) xv[r][j] = ((const f32x4*)((const float*)(ws + N_X1) + (size_t)(t + r) * D))[lane + 64 * j];
#pragma unroll
    for (int r = 0; r < 2; ++r) {
#pragma unroll
        for (int j = 0; j < 4; ++j) acc[r][j] = (f32x4){0.f, 0.f, 0.f, 0.f};
#pragma unroll
        for (int k = 0; k < 4; ++k)
#pragma unroll
            for (int j = 0; j < 4; ++j) { const u32x2 w = yv[r][k][j]; const float g = gk[r][k];
                acc[r][j].x += g * __builtin_bit_cast(float, w.x << 16); acc[r][j].y += g * __builtin_bit_cast(float, w.x & 0xffff0000u);
                acc[r][j].z += g * __builtin_bit_cast(float, w.y << 16); acc[r][j].w += g * __builtin_bit_cast(float, w.y & 0xffff0000u); }
        f32x4 v[4]; float ss = 0.f;
#pragma unroll
        for (int j = 0; j < 4; ++j) { const f32x4 g2 = ((const f32x4*)(mod + b * 6144 + 5120))[lane + 64 * j];
            v[j] = xv[r][j] + g2 * acc[r][j]; ss += (v[j].x * v[j].x + v[j].y * v[j].y) + (v[j].z * v[j].z + v[j].w * v[j].w); }
        const float rstd = rsqrtf(wave_sum(ss) * (1.f / D) + 1e-6f);
#pragma unroll
        for (int j = 0; j < 4; ++j) ((f32x4*)(P.out + (size_t)(t + r) * D))[lane + 64 * j] = v[j] * rstd * ((const f32x4*)P.in[17])[lane + 64 * j];
    }
}
__device__ __forceinline__ void phase_final(const Params& P, int vcu, int G, int wave, int lane) {
    const float* mod = (const float*)(P.ws + N_MOD);
    const int gw = vcu * NWAVES + wave, NGW = G * NWAVES;
    for (int t = gw * 2; t < T; t += NGW * 2) final_pair(P, mod, t, lane);
}
}
namespace mk {
constexpr size_t N_HGB = 802 * MiB;
constexpr size_t HG_UT = N_HGB;
constexpr size_t HG_OI = N_HGB + 32 * MiB;
constexpr size_t HG_QT = N_HGB + 64 * MiB;
constexpr size_t HG_DEC = N_HGB + 72 * MiB;
constexpr size_t HG_ST = N_HGB + 73 * MiB;
constexpr size_t N_END_D = N_HGB + 89 * MiB;
constexpr int HG_FLAG = 1024;
constexpr int H_LB = 0, H_TOT = 16384, H_QS = 18432, H_KS = H_QS + 9216, H_KT = H_KS + 4 * 9216, H_VT = H_KT + 9216, H_AM = H_VT + 18432, H_END = H_AM + 9216;
typedef float f32x4v __attribute__((ext_vector_type(4)));
#define MFMA16(a, b, c) __builtin_amdgcn_mfma_f32_16x16x32_bf16(a, b, c, 0, 0, 0)

__device__ __forceinline__ void hgrn_local_unit(const Params& P, LAS unsigned char* lds, int u, int wave, int lane) {
    unsigned char* ws = P.ws; const int tid = threadIdx.x;
    const int bh = u >> 6, c = u & 63, b = bh >> 2, h = bh & 3;
    const size_t row0 = (size_t)b * S + c * 64;
    LAS float* LB = (LAS float*)(lds + H_LB); LAS float* TOT = (LAS float*)(lds + H_TOT);
    LAS bf16* QS = (LAS bf16*)(lds + H_QS); LAS bf16* KS = (LAS bf16*)(lds + H_KS); LAS bf16* KT = (LAS bf16*)(lds + H_KT); LAS bf16* VT = (LAS bf16*)(lds + H_VT); LAS bf16* AM = (LAS bf16*)(lds + H_AM);
    const int t = tid >> 3, d0 = (tid & 7) * 8;
    float qf[8], kf[8], bc[8];
    {
        const float* fbp = (const float*)(ws + N_FB) + (row0 + t) * 256 + h * 64 + d0; const float* lbp = (const float*)(ws + N_LB) + h * 64 + d0;
        const f32x4 f0 = *(const f32x4*)fbp, f1 = *(const f32x4*)(fbp + 4), l0 = *(const f32x4*)lbp, l1 = *(const f32x4*)(lbp + 4);
        const u32x4 qv = *(const u32x4*)((const bf16*)(ws + N_QB) + (row0 + t) * 256 + h * 64 + d0);
#pragma unroll
        for (int j = 0; j < 8; ++j) {
            const float fb = j < 4 ? f0[j] : f1[j - 4], lb = j < 4 ? l0[j] : l1[j - 4];
            const float sg = 1.f / (1.f + __expf(-fb));
            const float f = lb + (1.f - lb) * sg;
            bc[j] = __logf(f); kf[j] = (1.f - lb) * (1.f - sg);
            const unsigned w = qv[j >> 1]; qf[j] = __builtin_bit_cast(float, (j & 1) ? (w & 0xffff0000u) : (w << 16));
            LB[t * 64 + d0 + j] = bc[j];
        }
    }
    for (int i = tid; i < 576; i += NTHR) ((LAS u32x4*)AM)[i] = (u32x4){0u, 0u, 0u, 0u};
#pragma unroll
    for (int i = 0; i < 2; ++i) { const int id = tid + 512 * i, s = id >> 4, e0 = (id & 15) * 8;
        const u32x4 v = *(const u32x4*)((const bf16*)(ws + N_IB) + (row0 + s) * 512 + h * 128 + e0);
#pragma unroll
        for (int j = 0; j < 8; ++j) VT[(e0 + j) * 72 + s] = (bf16)((j & 1) ? (v[j >> 1] >> 16) : (v[j >> 1] & 0xffffu)); }
    __syncthreads();
    { float a = 0.f;
#pragma unroll
      for (int r = 0; r < 8; ++r) { a += LB[(wave * 8 + r) * 64 + lane]; LB[(wave * 8 + r) * 64 + lane] = a; } }
    __syncthreads();
    if (wave == 0) { float a = 0.f;
#pragma unroll
        for (int g = 0; g < 8; ++g) { TOT[g * 64 + lane] = a; a += LB[(g * 8 + 7) * 64 + lane]; } }
    __syncthreads();
#pragma unroll
    for (int j = 0; j < 8; ++j) bc[j] = LB[t * 64 + d0 + j] + TOT[(t >> 3) * 64 + d0 + j];
    __syncthreads();
#pragma unroll
    for (int j = 0; j < 8; ++j) LB[t * 64 + d0 + j] = bc[j];
    __syncthreads();
    {
        const int I = t >> 4;
        float rI[8], bl[8];
#pragma unroll
        for (int j = 0; j < 8; ++j) { rI[j] = I ? LB[(16 * I - 1) * 64 + d0 + j] : 0.f; bl[j] = LB[63 * 64 + d0 + j]; }
        unsigned pq[4], pt[4];
#pragma unroll
        for (int j = 0; j < 8; j += 2) { pq[j >> 1] = pk2(qf[j] * __expf(bc[j] - rI[j]), qf[j + 1] * __expf(bc[j + 1] - rI[j + 1])); pt[j >> 1] = pk2(qf[j] * __expf(bc[j]), qf[j + 1] * __expf(bc[j + 1])); }
        *(LAS u32x4*)(QS + t * 72 + d0) = (u32x4){pq[0], pq[1], pq[2], pq[3]};
        *(u32x4*)((bf16*)(ws + HG_QT) + ((size_t)u * 64 + t) * 64 + d0) = (u32x4){pt[0], pt[1], pt[2], pt[3]};
#pragma unroll
        for (int I2 = 0; I2 < 4; ++I2) if (I2 >= I) {
            unsigned pk[4];
#pragma unroll
            for (int j = 0; j < 8; j += 2) { const float r0 = I2 ? LB[(16 * I2 - 1) * 64 + d0 + j] : 0.f, r1 = I2 ? LB[(16 * I2 - 1) * 64 + d0 + j + 1] : 0.f;
                pk[j >> 1] = pk2(kf[j] * __expf(r0 - bc[j]), kf[j + 1] * __expf(r1 - bc[j + 1])); }
            *(LAS u32x4*)(KS + I2 * 4608 + t * 72 + d0) = (u32x4){pk[0], pk[1], pk[2], pk[3]};
        }
#pragma unroll
        for (int j = 0; j < 8; ++j) KT[(d0 + j) * 72 + t] = (bf16)f2bf(kf[j] * __expf(bl[j] - bc[j]));
        if (t == 63) {
#pragma unroll
            for (int j = 0; j < 8; ++j) ((float*)(ws + HG_DEC))[(size_t)u * 64 + d0 + j] = __expf(bl[j]);
        }
    }
    __syncthreads();
    const int lr = lane & 15, lq = lane >> 4;
    for (int ti = wave; ti < 10; ti += NWAVES) {
        const int I = ti < 1 ? 0 : ti < 3 ? 1 : ti < 6 ? 2 : 3, J = ti - (I * (I + 1)) / 2;
        f32x4v acc = {0.f, 0.f, 0.f, 0.f};
#pragma unroll
        for (int kk = 0; kk < 2; ++kk) { const bf16x8 a = *(const LAS bf16x8*)(QS + (16 * I + lr) * 72 + 32 * kk + 8 * lq), bb = *(const LAS bf16x8*)(KS + I * 4608 + (16 * J + lr) * 72 + 32 * kk + 8 * lq);
            acc = MFMA16(a, bb, acc); }
#pragma unroll
        for (int r = 0; r < 4; ++r) { const int tt = 16 * I + 4 * lq + r, ss = 16 * J + lr; AM[tt * 72 + ss] = (bf16)f2bf(ss <= tt ? acc[r] : 0.f); }
    }
    __syncthreads();
    if (wave < 4) {
#pragma unroll
        for (int et = 0; et < 8; ++et) { f32x4v acc = {0.f, 0.f, 0.f, 0.f};
#pragma unroll
            for (int kk = 0; kk < 2; ++kk) { const bf16x8 a = *(const LAS bf16x8*)(AM + (16 * wave + lr) * 72 + 32 * kk + 8 * lq), bb = *(const LAS bf16x8*)(VT + (16 * et + lr) * 72 + 32 * kk + 8 * lq);
                acc = MFMA16(bb, a, acc); }
            ((f32x4v*)(ws + HG_OI))[(((size_t)u * 4 + wave) * 8 + et) * 64 + lane] = acc; }
    } else {
        const int dI = wave - 4;
#pragma unroll
        for (int et = 0; et < 8; ++et) { f32x4v acc = {0.f, 0.f, 0.f, 0.f};
#pragma unroll
            for (int kk = 0; kk < 2; ++kk) { const bf16x8 a = *(const LAS bf16x8*)(KT + (16 * dI + lr) * 72 + 32 * kk + 8 * lq), bb = *(const LAS bf16x8*)(VT + (16 * et + lr) * 72 + 32 * kk + 8 * lq);
                acc = MFMA16(a, bb, acc); }
            *(f32x4v*)((float*)(ws + HG_UT) + ((size_t)u * 128 + 16 * et + lr) * 64 + 16 * dI + 4 * lq) = acc; }
    }
    __syncthreads();
}

__device__ __forceinline__ void hgrn_scan(const Params& P) {
    unsigned char* ws = P.ws;
    for (int ch = blockIdx.x; ch < 256; ch += gridDim.x) {
        const int gid = ch * NTHR + threadIdx.x;
        const int bh = gid >> 13, ed = gid & 8191, d = gid & 63;
        const float* ut = (const float*)(ws + HG_UT) + (size_t)bh * 64 * 8192 + ed; const float* dec = (const float*)(ws + HG_DEC) + (size_t)bh * 64 * 64 + d;
        bf16* st = (bf16*)(ws + HG_ST) + (size_t)bh * 64 * 8192 + ed;
        float sreg = 0.f;
        for (int c0 = 0; c0 < 64; c0 += 16) {
            float uu[16], dc[16];
#pragma unroll
            for (int c = 0; c < 16; ++c) { uu[c] = ut[(size_t)(c0 + c) * 8192]; dc[c] = dec[(c0 + c) * 64]; }
#pragma unroll
            for (int c = 0; c < 16; ++c) { __hip_atomic_store(st + (size_t)(c0 + c) * 8192, (bf16)f2bf(sreg), __ATOMIC_RELAXED, __HIP_MEMORY_SCOPE_AGENT); sreg = dc[c] * sreg + uu[c]; }
        }
        asm volatile("s_waitcnt vmcnt(0)" ::: "memory");
        __syncthreads();
        if (threadIdx.x == 0) __hip_atomic_fetch_add((int*)(ws + N_CTL + HG_FLAG) + (ch >> 4), 1, __ATOMIC_RELAXED, __HIP_MEMORY_SCOPE_AGENT);
    }
}

__device__ __forceinline__ void hgrn_wait_scans(const Params& P) {
    if (threadIdx.x < 64) {
        const int* flag = (const int*)(P.ws + N_CTL + HG_FLAG) + (threadIdx.x & 15); unsigned spins = 0;
        while (!__all(__hip_atomic_load(flag, __ATOMIC_RELAXED, __HIP_MEMORY_SCOPE_AGENT) >= 16)) { __builtin_amdgcn_s_sleep(2); if (++spins > (1u << 22)) break; }
        __builtin_amdgcn_fence(__ATOMIC_ACQUIRE, "agent");
        asm volatile("s_waitcnt vmcnt(0)" ::: "memory");
    }
    __syncthreads();
}
struct HOut { int u, I, b, c, h; size_t trow; };
__device__ __forceinline__ HOut hout_of(int task, int lr) { HOut t; t.u = task >> 2; t.I = task & 3; const int bh = t.u >> 6; t.c = t.u & 63; t.b = bh >> 2; t.h = bh & 3;
    t.trow = (size_t)t.b * S + t.c * 64 + 16 * t.I + lr; return t; }
__device__ __forceinline__ void hout_load(const Params& P, const HOut& t, int lane, u32x2 (&gbv)[8], f32x4v (&acc)[8], bf16x8 (&a)[2]) {
    unsigned char* ws = P.ws; const int lr = lane & 15, lq = lane >> 4;
#pragma unroll
    for (int et = 0; et < 8; ++et) gbv[et] = *(const u32x2*)((const bf16*)(ws + N_GB) + t.trow * 512 + t.h * 128 + 16 * et + 4 * lq);
#pragma unroll
    for (int et = 0; et < 8; ++et) acc[et] = ((const f32x4v*)(ws + HG_OI))[(((size_t)t.u * 4 + t.I) * 8 + et) * 64 + lane];
#pragma unroll
    for (int kk = 0; kk < 2; ++kk) a[kk] = *(const bf16x8*)((const bf16*)(ws + HG_QT) + ((size_t)t.u * 64 + 16 * t.I + lr) * 64 + 32 * kk + 8 * lq);
}
__device__ __forceinline__ void hout_finish(const Params& P, const HOut& t, int lane, const u32x2 (&gbv)[8], f32x4v (&acc)[8], const bf16x8 (&a)[2]) {
    unsigned char* ws = P.ws; const int lr = lane & 15, lq = lane >> 4;
#pragma unroll
    for (int et = 0; et < 8; ++et)
#pragma unroll
        for (int kk = 0; kk < 2; ++kk) { const bf16x8 bb = *(const bf16x8*)((const bf16*)(ws + HG_ST) + ((size_t)t.u * 128 + 16 * et + lr) * 64 + 32 * kk + 8 * lq); acc[et] = MFMA16(bb, a[kk], acc[et]); }
    float ss = 0.f;
#pragma unroll
    for (int et = 0; et < 8; ++et)
#pragma unroll
        for (int r = 0; r < 4; ++r) ss += acc[et][r] * acc[et][r];
    ss += __shfl_xor(ss, 16); ss += __shfl_xor(ss, 32);
    const float rstd = rsqrtf(ss * (1.f / 128.f) + 1e-6f);
#pragma unroll
    for (int et = 0; et < 8; ++et) { const f32x4v g = *(const f32x4v*)(P.in[7] + 16 * et + 4 * lq);
        float o[4];
#pragma unroll
        for (int r = 0; r < 4; ++r) { const unsigned w = gbv[et][r >> 1]; const float gb = __builtin_bit_cast(float, (r & 1) ? (w & 0xffff0000u) : (w << 16));
            o[r] = acc[et][r] * rstd * g[r] * gb * __builtin_amdgcn_rcpf(1.f + __expf(-gb)); }
        u32x2 ow; ow.x = pk2(o[0], o[1]); ow.y = pk2(o[2], o[3]);
        *(u32x2*)((bf16*)(ws + N_MIX) + t.trow * 1024 + 512 + t.h * 128 + 16 * et + 4 * lq) = ow; }
}
__device__ __forceinline__ void hgrn_out_pair(const Params& P, int task0, int task1, int lane) {
    const int lr = lane & 15;
    const HOut t0 = hout_of(task0, lr), t1 = hout_of(task1, lr);
    u32x2 g0[8], g1[8]; f32x4v c0[8], c1[8]; bf16x8 a0[2], a1[2];
    hout_load(P, t0, lane, g0, c0, a0); hout_load(P, t1, lane, g1, c1, a1);
    hout_finish(P, t0, lane, g0, c0, a0); hout_finish(P, t1, lane, g1, c1, a1);
}
__device__ __forceinline__ void hgrn_out_task(const Params& P, int task, int lane) {
    const HOut t = hout_of(task, lane & 15); u32x2 g[8]; f32x4v c[8]; bf16x8 a[2];
    hout_load(P, t, lane, g, c, a); hout_finish(P, t, lane, g, c, a);
}
}
namespace mk {
template <int K>
__device__ __forceinline__ void run_phase(const Params& P, LAS unsigned char* lds, int vcu, int G, int bx, int wave, int lane) {
    if constexpr (K == 0) phase0(P, lds, vcu, G, wave, lane);
    if constexpr (K == 1) phase1a(P, vcu, G, wave, lane);
    if constexpr (K == 2) {
        pg8::Gemm g{(const pg8::bf16_t*)(P.ws + N_HB), (const pg8::bf16_t*)(P.ws + N_WTIN), T, NPAD, D};
        pg8::StaticOrder So; So.init(T, NPAD, G, bx);
        EpiProj E{P.ws};
        pg8::gemm_phase<EpiProj, pg8::StaticOrder, true, true>(lds, g, So, E);
    }
    if constexpr (K == 3) { phase_index(P, lds, vcu, G, wave, lane, P.mask_old); __syncthreads(); for (int u = vcu; u < 1024; u += G) hgrn_local_unit(P, lds, u, wave, lane); }
    if constexpr (K == 4) { hgrn_scan(P); phase_attn(P, lds, vcu, G, wave, lane); hgrn_wait_scans(P); { const int tk0 = vcu * NWAVES + wave, st = G * NWAVES; if (st == 2048) hgrn_out_pair(P, tk0, tk0 + 2048, lane); else for (int tk = tk0; tk < 4096; tk += st) hgrn_out_task(P, tk, lane); } }
    if constexpr (K == 5) {
        pg8::Gemm g{(const pg8::bf16_t*)(P.ws + N_MIX), (const pg8::bf16_t*)(P.ws + N_WTOUT), T, D, D};
        pg8::StaticOrder So; So.init(T, D, G, bx);
        EpiX1 E{P.in[0], (const float*)(P.ws + N_MOD), (float*)(P.ws + N_X1)};
        pg8::gemm_phase<EpiX1, pg8::StaticOrder, true, true>(lds, g, So, E);
    }
    if constexpr (K == 6) phase_route(P, lds, vcu, G, wave, lane);
    if constexpr (K == 7) { phase_scatter(P, lds, vcu, G, wave, lane); }
    if constexpr (K == 8) {
        LAS int* ps = (LAS int*)(lds + LDS_MISC); LAS int* blke = ps + 64;
        const int nrb = moe_tables((const int*)(P.ws + N_CTL), ps, blke);
        pg8::Gemm g{(const pg8::bf16_t*)(P.ws + N_HB), (const pg8::bf16_t*)(P.ws + N_W1T), NROWS, 32 * 2048, D};
        MoeOrder<8, true> So{blke, nrb * 8, G, bx, (const int*)(P.ws + N_TOK)};
        EpiSwiglu E{P.in[14], (bf16*)(P.ws + N_ACT)};
        pg8::gemm_phase<EpiSwiglu, MoeOrder<8, true>, true, true>(lds, g, So, E);
    }
    if constexpr (K == 9) {
        LAS int* ps = (LAS int*)(lds + LDS_MISC); LAS int* blke = ps + 64;
        const int nrb = moe_tables((const int*)(P.ws + N_CTL), ps, blke);
        pg8::Gemm g{(const pg8::bf16_t*)(P.ws + N_ACT), (const pg8::bf16_t*)(P.ws + N_W2T), NROWS, 32 * 1024, D};
        MoeOrder<4, false> So{blke, nrb * 4, G, bx, nullptr};
        EpiY E{P.in[16], (bf16*)(P.ws + N_Y)};
        pg8::gemm_phase<EpiY, MoeOrder<4, false>, true, true>(lds, g, So, E);
    }
    if constexpr (K == 10) phase_final(P, vcu, G, wave, lane);

}
__global__ void __launch_bounds__(NTHR, 2) mk_fwd(Params P) {
    extern __shared__ __attribute__((aligned(16))) unsigned char lds_raw[];
    LAS unsigned char* lds = (LAS unsigned char*)lds_raw;
    const int tid = threadIdx.x, lane = tid & 63, wave = __builtin_amdgcn_readfirstlane(tid >> 6);
    const int G = gridDim.x; const int bx = blockIdx.x; const int vcu = (G % 8 == 0) ? (bx % 8) * (G / 8) + bx / 8 : bx;
    volatile LAS unsigned* xst = (volatile LAS unsigned*)(lds + LDS_BYTES - 256);
    if (tid < 2) xst[tid] = 0u;
    __syncthreads();
    XcdBarrier xbar = xcd_barrier_post((unsigned*)(P.ws + N_CTL + 8192), xst);
#define RUN(k) do { if ((P.prog >> (k)) & 1ull) run_phase<k>(P, lds, vcu, G, bx, wave, lane); } while (0)
#define SYNC0() xcd_barrier(xbar)
#define SYNC() xcd_barrier(xbar)
     RUN(0); SYNC0(); RUN(1); SYNC(); RUN(2); SYNC(); RUN(3); SYNC(); RUN(4); SYNC(); RUN(5); SYNC(); RUN(6); SYNC(); RUN(7); SYNC(); RUN(8); SYNC(); RUN(9); SYNC(); RUN(10);
#undef RUN
#undef SYNC
#undef SYNC0
}
}
extern "C" void kernel_launch(void* const* d_in, const int* in_sizes, int n_in, void* d_out, int out_size, void* d_ws, size_t ws_size, hipStream_t stream) {
    if (ws_size < mk::N_END_D) { fprintf(stderr, "kernel_launch: workspace too small (%zu)\n", ws_size); return; }
    static int grid = 0;
    if (!grid) {
        int dev = 0, cus = 0, per_cu = 0;
        (void)hipGetDevice(&dev); (void)hipDeviceGetAttribute(&cus, hipDeviceAttributeMultiprocessorCount, dev);
        (void)hipFuncSetAttribute((const void*)mk::mk_fwd, hipFuncAttributeMaxDynamicSharedMemorySize, mk::LDS_BYTES);
        (void)hipOccupancyMaxActiveBlocksPerMultiprocessor(&per_cu, (const void*)mk::mk_fwd, mk::NTHR, mk::LDS_BYTES);
        grid = 256;
        if (cus < 256 || per_cu < 1) { fprintf(stderr, "kernel_launch: needs 256 CUs with one resident 512-thread workgroup each (have %d CUs, %d per CU); nothing launched\n", cus, per_cu); grid = -1; }
    }
    if (grid < 0) return;
    (void)hipMemsetAsync((char*)d_ws + mk::N_CTL, 0, 32768, stream);
    mk::Params P{};
    for (int i = 0; i < 18; ++i) P.in[i] = (const float*)d_in[i];
    P.out = (float*)d_out; P.ws = (unsigned char*)d_ws; P.mask_old = nullptr;  P.prog = 0xfffull; P.nprog = 0;
    void* args[] = {&P};
    hipError_t e = hipLaunchCooperativeKernel((const void*)mk::mk_fwd, dim3(grid), dim3(mk::NTHR), args, mk::LDS_BYTES, stream);
    if (e != hipSuccess) fprintf(stderr, "cooperative launch failed: %s (grid %d)\n", hipGetErrorString(e), grid);
}
```

```cpp
#include <hip/hip_runtime.h>
#include <stdint.h>
#include <hip/hip_cooperative_groups.h>
#include <cstdio>
namespace cg = cooperative_groups;
constexpr int NB = 4, S = 4096, D = 1024, T = NB * S;
constexpr int DIN = 3396;
constexpr int NE = 32, NROWS = (T * 4 / 256 + NE) * 256;
constexpr size_t MiB = 1u << 20;
#ifdef PROBE_A
#define PROBE_STAMP(P_, id) do { if (threadIdx.x == 0) { const unsigned long long t_ = wall_clock64(); \
    if ((id) == PROBE_A) __hip_atomic_store((unsigned long long*)((P_).ws + mk::N_CTL + 131072) + blockIdx.x * 2, t_, __ATOMIC_RELAXED, __HIP_MEMORY_SCOPE_AGENT); \
    if ((id) == PROBE_B) __hip_atomic_store((unsigned long long*)((P_).ws + mk::N_CTL + 131072) + blockIdx.x * 2 + 1, t_, __ATOMIC_RELAXED, __HIP_MEMORY_SCOPE_AGENT); } } while (0)
#else
#define PROBE_STAMP(P_, id) do {} while (0)
#endif
#if defined(PROBE_A) && defined(PROBE_PID)
#define PROBE_LACC(lds_, pid, slot) do { if ((pid) == PROBE_PID && threadIdx.x == 0) { const unsigned long long t_ = wall_clock64(); \
    volatile __attribute__((address_space(3))) unsigned long long* L_ = (volatile __attribute__((address_space(3))) unsigned long long*)((lds_) + 163840 - 64); \
    if ((slot) > 0) L_[slot] += t_ - L_[0]; L_[0] = t_; } } while (0)
#else
#define PROBE_LACC(lds_, pid, slot) do {} while (0)
#endif
namespace pg8 {
#define PG8_LAS __attribute__((address_space(3)))
typedef unsigned short bf16_t;
typedef short bf16x8 __attribute__((ext_vector_type(8)));
typedef float f32x4 __attribute__((ext_vector_type(4)));
typedef unsigned u32x4 __attribute__((ext_vector_type(4)));
constexpr int BM = 256, BK = 64, HALF = 128, HTB = HALF * BK * 2  , STAGE_BYTES = 8 * HTB, NXCD = 8, WGM = 8;

__host__ __device__ __forceinline__ int lds_byte(int r, int c) { const int st = (r >> 4) * 2 + (c >> 5), rr = r & 15, cc = c & 31, ob = rr * 64 + cc * 2; return st * 1024 + (ob ^ (((ob >> 9) & 1) << 5)); }
__host__ __device__ __forceinline__ void stage_rc(int b, int& R, int& C) { const int st = b / 1024, sb = b % 1024, swz = sb ^ (((sb >> 9) & 1) << 5); R = (st >> 1) * 16 + swz / 64; C = (st & 1) * 32 + (swz % 64) / 2; }
__host__ __device__ __forceinline__ int perm32(int rho) { const int n = rho >> 4, i = rho & 15; return 8 * (i >> 2) + 4 * n + (i & 3); }

struct Unit { int pm, pn; };
struct Gemm { const bf16_t* A; const bf16_t* Bt; int M, N, K; };

struct StaticOrder {
    static constexpr bool GATHER = false; const int* tok = nullptr;
    int nM, nN, nwg, G, c;
    __host__ __device__ void init(int M, int N, int G_, int c_) { nM = M / BM; nN = N / BM; nwg = nM * nN; G = G_; c = c_; }
    __host__ __device__ bool next(int i, Unit& u) const {
        const long L = (long)i * G + c; if (L >= nwg) return false;
        int wgid = (int)L; { const int q = nwg / NXCD, r = nwg % NXCD, xcd = wgid % NXCD, off = wgid / NXCD; wgid = (xcd < r ? xcd * (q + 1) : r * (q + 1) + (xcd - r) * q) + off; }
        const int nig = WGM * nN, gid = wgid / nig, fm = gid * WGM, gsz = (nM - fm) < WGM ? (nM - fm) : WGM;
        u.pm = fm + ((wgid % nig) % gsz); u.pn = (wgid % nig) / gsz; return true;
    }
    __device__ __forceinline__ void a_ready(const Unit&) const {}
    __device__ __forceinline__ void done(const Unit&) const {}
};
__device__ __forceinline__ unsigned cvt_pk_bf16(float lo, float hi) { unsigned r; asm volatile("v_cvt_pk_bf16_f32 %0, %1, %2" : "=v"(r) : "v"(lo), "v"(hi)); return r; }
typedef float f32x2 __attribute__((ext_vector_type(2)));
template <class Epi, class Sched, bool ALIGN_EPI = false, bool SP2 = false>
__device__ __forceinline__ void gemm_phase(PG8_LAS unsigned char* lds, const Gemm g, const Sched& S, const Epi& E) {
    const int tid = threadIdx.x, wid = __builtin_amdgcn_readfirstlane(tid >> 6), lane = tid & 63, wr = wid >> 2, wc = wid & 3, fr = lane & 15, fq = lane >> 4;
    const int K = g.K, nt = K / BK;
    unsigned voffA[2], voffB[2]; int RA[2], CA[2];
#pragma unroll
    for (int i = 0; i < 2; ++i) { int R, C; stage_rc(tid * 16 + i * 8192, R, C); const int Rb = Epi::PERM ? ((R & ~31) + perm32(R & 31)) : R; RA[i] = R; CA[i] = C;
        voffA[i] = (unsigned)(R * K + C) * 2u; voffB[i] = (unsigned)(Rb * K + C) * 2u; }
    unsigned oc0[2], oc1[2], on0[2], on1[2];
#define PG8_OFFS(u, o0, o1) do { _Pragma("unroll") for (int i_ = 0; i_ < 2; ++i_) { \
        if constexpr (Sched::GATHER) { o0[i_] = (unsigned)S.tok[(u).pm * 256 + RA[i_]] * (unsigned)(K * 2) + (unsigned)CA[i_] * 2u; o1[i_] = (unsigned)S.tok[(u).pm * 256 + 128 + RA[i_]] * (unsigned)(K * 2) + (unsigned)CA[i_] * 2u; } \
        else { o0[i_] = voffA[i_]; o1[i_] = voffA[i_] + (unsigned)(HALF * K * 2); } } } while (0)
    const size_t kstep = (size_t)(BK * 2);
    const size_t hstep = (size_t)HALF * K * 2;
    const size_t tstep = 2 * hstep;
    const unsigned ldsw = (unsigned)wid * 1024u;
    const int aoff = lds_byte(wr * 64 + fr, fq * 8), boff = lds_byte(wc * 32 + fr, fq * 8);
#define PG8_SA(b, h) (((b) * 2 + (h)) * HTB)
#define PG8_SB(b, h) ((4 + (b) * 2 + (h)) * HTB)
#define PG8_STAGE(bufoff, gbase, voff) do { _Pragma("unroll") for (int _i = 0; _i < 2; ++_i) \
        __builtin_amdgcn_global_load_lds((const unsigned*)((const char*)(gbase) + (voff)[_i]), (PG8_LAS unsigned*)(lds + (bufoff) + ldsw + _i * 8192), 16, 0, 0); } while (0)
#define PG8_LDA(dst, b, h) do { _Pragma("unroll") for (int m = 0; m < 4; ++m) _Pragma("unroll") for (int k = 0; k < 2; ++k) dst[m][k] = *(const PG8_LAS bf16x8*)(lds + PG8_SA(b, h) + aoff + m * 2048 + k * 1024); } while (0)
#define PG8_LDB(dst, b, h) do { _Pragma("unroll") for (int n = 0; n < 2; ++n) _Pragma("unroll") for (int k = 0; k < 2; ++k) dst[n][k] = *(const PG8_LAS bf16x8*)(lds + PG8_SB(b, h) + boff + n * 2048 + k * 1024); } while (0)
#define PG8_MMA(ai, bj, At, Bt) do { __builtin_amdgcn_s_setprio(1); _Pragma("unroll") for (int m = 0; m < 4; ++m) _Pragma("unroll") for (int n = 0; n < 2; ++n) _Pragma("unroll") for (int k = 0; k < 2; ++k) \
        acc[ai][bj][m][n] = __builtin_amdgcn_mfma_f32_16x16x32_bf16(Bt[n][k], At[m][k], acc[ai][bj][m][n], 0, 0, 0); __builtin_amdgcn_s_setprio(0); } while (0)
#define PG8_WAIT_V(n) asm volatile("s_waitcnt vmcnt(" #n ")" ::: "memory")
#define PG8_WAIT_L(n) asm volatile("s_waitcnt lgkmcnt(" #n ")" ::: "memory")
#define PG8_BAR __builtin_amdgcn_s_barrier()
#define PG8_SCHED __builtin_amdgcn_sched_barrier(0)
    Unit cur, nxt; int ui = 0;
    if (!S.next(0, cur)) return;
    f32x4 acc[2][2][4][2];
#pragma unroll
    for (int a = 0; a < 2; ++a)
#pragma unroll
        for (int b = 0; b < 2; ++b)
#pragma unroll
            for (int m = 0; m < 4; ++m)
#pragma unroll
                for (int n = 0; n < 2; ++n) acc[a][b][m][n] = (f32x4){0.f, 0.f, 0.f, 0.f};
    bf16x8 At[4][2], B0[2][2], B1[2][2];
    const char* cA = (const char*)g.A + (Sched::GATHER ? (size_t)0 : (size_t)cur.pm * tstep); const char* cB = (const char*)g.Bt + (size_t)cur.pn * tstep;
    PG8_OFFS(cur, oc0, oc1);
    PROBE_LACC(lds, Epi::PID, 0);
    S.a_ready(cur);
    if constexpr (SP2) {
        PG8_STAGE(PG8_SB(0, 0), cB, voffB); PG8_STAGE(PG8_SB(0, 1), cB + hstep, voffB); PG8_STAGE(PG8_SA(0, 0), cA, oc0); PG8_STAGE(PG8_SA(0, 1), cA, oc1);
        if (wr == 1) PG8_BAR;
        PG8_WAIT_V(2); PG8_BAR;
        PG8_STAGE(PG8_SB(1, 0), cB + kstep, voffB); PG8_STAGE(PG8_SA(1, 0), cA + kstep, oc0); PG8_STAGE(PG8_SB(1, 1), cB + hstep + kstep, voffB);
        PG8_WAIT_V(6); PG8_BAR;
    } else {
        PG8_STAGE(PG8_SB(0, 0), cB, voffB); PG8_STAGE(PG8_SA(0, 0), cA, oc0); PG8_STAGE(PG8_SB(0, 1), cB + hstep, voffB); PG8_STAGE(PG8_SA(0, 1), cA, oc1);
        if (wr == 1) PG8_BAR;
        PG8_WAIT_V(4); PG8_BAR;
        PG8_STAGE(PG8_SB(1, 0), cB + kstep, voffB); PG8_STAGE(PG8_SA(1, 0), cA + kstep, oc0); PG8_STAGE(PG8_SB(1, 1), cB + hstep + kstep, voffB);
        PG8_WAIT_V(6); PG8_BAR;
    }
    for (;;) {
        const bool has_next = S.next(ui + 1, nxt);
        const char* nA = has_next ? (const char*)g.A + (Sched::GATHER ? (size_t)0 : (size_t)nxt.pm * tstep) : cA;
        if (has_next) PG8_OFFS(nxt, on0, on1); else { on0[0] = oc0[0]; on0[1] = oc0[1]; on1[0] = oc1[0]; on1[1] = oc1[1]; }
        const char* nB = has_next ? (const char*)g.Bt + (size_t)nxt.pn * tstep : cB;
        PROBE_LACC(lds, Epi::PID, 3);
        for (int t = 0; t < nt; t += 2) {
            const bool last = (t == nt - 2);
            const char* a1 = cA + (size_t)(t + 1) * kstep;
            const char* a2 = last ? nA : cA + (size_t)(t + 2) * kstep; const char* b2 = last ? nB : cB + (size_t)(t + 2) * kstep;
            const char* a3 = a2 + kstep; const char* b3 = b2 + kstep;
            const unsigned x0[2] = {last ? on0[0] : oc0[0], last ? on0[1] : oc0[1]}, x1[2] = {last ? on1[0] : oc1[0], last ? on1[1] : oc1[1]};
            if (last && has_next) S.a_ready(nxt);
            if constexpr (SP2) {
            PG8_LDB(B0, 0, 0); PG8_LDB(B1, 0, 1); PG8_SCHED; PG8_LDA(At, 0, 0); PG8_STAGE(PG8_SA(1, 1), a1, oc1);
            PG8_WAIT_V(8); PG8_WAIT_L(0); PG8_BAR; PG8_MMA(0, 0, At, B0); PG8_MMA(0, 1, At, B1); PG8_BAR; PG8_SCHED;
            PG8_LDA(At, 0, 1); PG8_STAGE(PG8_SB(0, 0), b2, voffB); PG8_STAGE(PG8_SB(0, 1), b2 + hstep, voffB); PG8_STAGE(PG8_SA(0, 0), a2, x0);
            PG8_WAIT_V(8); PG8_WAIT_L(0); PG8_BAR; PG8_MMA(1, 0, At, B0); PG8_MMA(1, 1, At, B1); PG8_BAR; PG8_SCHED;
            PG8_LDB(B0, 1, 0); PG8_LDB(B1, 1, 1); PG8_SCHED; PG8_LDA(At, 1, 0); PG8_STAGE(PG8_SA(0, 1), a2, x1);
            PG8_WAIT_V(8); PG8_WAIT_L(0); PG8_BAR; PG8_MMA(0, 0, At, B0); PG8_MMA(0, 1, At, B1); PG8_BAR; PG8_SCHED;
            PG8_LDA(At, 1, 1); PG8_STAGE(PG8_SB(1, 0), b3, voffB); PG8_STAGE(PG8_SB(1, 1), b3 + hstep, voffB); PG8_STAGE(PG8_SA(1, 0), a3, x0);
            PG8_WAIT_V(8); PG8_WAIT_L(0); PG8_BAR; PG8_MMA(1, 0, At, B0); PG8_MMA(1, 1, At, B1); PG8_BAR; PG8_SCHED;
            } else {
            PG8_LDB(B0, 0, 0); PG8_SCHED; PG8_LDA(At, 0, 0); PG8_STAGE(PG8_SA(1, 1), a1, oc1);
            PG8_WAIT_L(8); PG8_BAR; PG8_WAIT_L(0); PG8_MMA(0, 0, At, B0); PG8_BAR; PG8_SCHED;
            PG8_LDB(B1, 0, 1); PG8_STAGE(PG8_SB(0, 0), b2, voffB);
            PG8_BAR; PG8_WAIT_L(0); PG8_MMA(0, 1, At, B1); PG8_BAR;
            PG8_LDA(At, 0, 1); PG8_STAGE(PG8_SA(0, 0), a2, x0);
            PG8_BAR; PG8_WAIT_L(0); PG8_MMA(1, 0, At, B0); PG8_BAR; PG8_SCHED;
            PG8_STAGE(PG8_SB(0, 1), b2 + hstep, voffB);
            PG8_WAIT_V(6); PG8_BAR; PG8_MMA(1, 1, At, B1); PG8_BAR;
            PG8_LDB(B0, 1, 0); PG8_SCHED; PG8_LDA(At, 1, 0); PG8_STAGE(PG8_SA(0, 1), a2, x1);
            PG8_WAIT_L(8); PG8_BAR; PG8_WAIT_L(0); PG8_MMA(0, 0, At, B0); PG8_BAR; PG8_SCHED;
            PG8_LDB(B1, 1, 1); PG8_STAGE(PG8_SB(1, 0), b3, voffB);
            PG8_BAR; PG8_WAIT_L(0); PG8_MMA(0, 1, At, B1); PG8_BAR;
            PG8_LDA(At, 1, 1); PG8_STAGE(PG8_SA(1, 0), a3, x0);
            PG8_BAR; PG8_WAIT_L(0); PG8_MMA(1, 0, At, B0); PG8_BAR; PG8_SCHED;
            PG8_STAGE(PG8_SB(1, 1), b3 + hstep, voffB);
            PG8_WAIT_V(6); PG8_BAR; PG8_MMA(1, 1, At, B1); PG8_BAR;
            }
        }
        PROBE_LACC(lds, Epi::PID, 1);
        if constexpr (ALIGN_EPI) { if (wr == 0) PG8_BAR; }
        if constexpr (!Epi::AFTER_DRAIN) { E(acc, cur, wr, wc, fr, fq); S.done(cur); }
        PROBE_LACC(lds, Epi::PID, 2);
        if (!has_next) break;
#pragma unroll
        for (int a = 0; a < 2; ++a)
#pragma unroll
            for (int b = 0; b < 2; ++b)
#pragma unroll
                for (int m = 0; m < 4; ++m)
#pragma unroll
                    for (int n = 0; n < 2; ++n) acc[a][b][m][n] = (f32x4){0.f, 0.f, 0.f, 0.f};
        cur = nxt; cA = nA; cB = nB; ++ui; oc0[0] = on0[0]; oc0[1] = on0[1]; oc1[0] = on1[0]; oc1[1] = on1[1];
        if constexpr (ALIGN_EPI) { if (wr == 1) PG8_BAR; }
    }
    PG8_WAIT_V(0);
    if constexpr (!ALIGN_EPI) { if (wr == 0) PG8_BAR; }
    PG8_BAR;
    if constexpr (Epi::AFTER_DRAIN) { E.fused(acc, cur, wr, wc, fr, fq, lds, wid, lane); S.done(cur); }
#undef PG8_OFFS
#undef PG8_SA
#undef PG8_SB
#undef PG8_STAGE
#undef PG8_LDA
#undef PG8_LDB
#undef PG8_MMA
#undef PG8_WAIT_V
#undef PG8_WAIT_L
#undef PG8_BAR
#undef PG8_SCHED
}
}
namespace mk {
#define LAS __attribute__((address_space(3)))
typedef unsigned short bf16;
typedef float f32x4 __attribute__((ext_vector_type(4)));
typedef unsigned u32x4 __attribute__((ext_vector_type(4)));
typedef unsigned u32x2 __attribute__((ext_vector_type(2)));
constexpr int NWAVES = 8, NTHR = 512;
constexpr int LDS_BYTES = 163840;
constexpr float C2 = 0.125f * 1.4426950408889634f;
constexpr int NPAD = 3584;
constexpr int C_QA = 0, C_KA = 512, C_VA = 1024, C_QI = 1536, C_KI = 1792, C_QB = 1856, C_FB = 2112, C_IB = 2368, C_GB = 2880, C_WI = 3392;

constexpr size_t N_CTL = 0;
__device__ unsigned g_ctl[8192];
__device__ __forceinline__ unsigned char* ctl() { return (unsigned char*)g_ctl; }
constexpr int CTL_EXIT = 6144;
constexpr size_t N_MOD = 1 * MiB;
constexpr size_t N_LB = 1 * MiB + 128 * 1024;
constexpr size_t N_ROPE = 2 * MiB;
constexpr size_t N_WTIN = 4 * MiB;
constexpr size_t N_WTOUT = 12 * MiB;
constexpr size_t N_HB = 16 * MiB;
constexpr size_t N_X1 = 48 * MiB;
constexpr size_t N_QA = 112 * MiB, N_KA = 128 * MiB, N_VA = 144 * MiB;
constexpr size_t N_QI = 160 * MiB;
constexpr size_t N_KI = 168 * MiB;
constexpr size_t N_WI = 170 * MiB;
constexpr size_t N_QB = 172 * MiB;
constexpr size_t N_FB = 180 * MiB;
constexpr size_t N_IB = 196 * MiB, N_GB = 212 * MiB;
constexpr size_t N_MASKT = 228 * MiB;
constexpr size_t N_MIX = 236 * MiB;
constexpr size_t N_SCORE = 268 * MiB;
constexpr size_t N_HG = 396 * MiB;
constexpr size_t N_W1T = 466 * MiB;
constexpr size_t N_W2T = 594 * MiB;
constexpr size_t N_END_A = 658 * MiB;

__device__ __forceinline__ unsigned f2bf(float f) { unsigned u = __builtin_bit_cast(unsigned, f); return (u + 0x7fffu + ((u >> 16) & 1u)) >> 16; }
__device__ __forceinline__ unsigned pk2(float lo, float hi) { unsigned r; asm volatile("v_cvt_pk_bf16_f32 %0, %1, %2" : "=v"(r) : "v"(lo), "v"(hi)); return r; }
__device__ __forceinline__ float bf2f(unsigned short b) { return __builtin_bit_cast(float, (unsigned)b << 16); }
__device__ __forceinline__ float wave_sum(float v) {
#pragma unroll
    for (int o = 1; o < 64; o <<= 1) v += __shfl_xor(v, o);
    return v;
}

struct Params {
    const float* in[18]; float* out; unsigned char* ws; unsigned long long* mask_old; unsigned long long prog; int nprog, pad;
};

struct EpiProj {
    static constexpr bool PERM = true, AFTER_DRAIN = false; static constexpr int PID = 2;
    unsigned char* ws;
    __device__ __forceinline__ void operator()(const pg8::f32x4 (&acc)[2][2][4][2], const pg8::Unit& u, int wr, int wc, int fr, int fq) const {
        const int row0 = u.pm * 256 + wr * 64 + fr;
        const float* rope = (const float*)(ws + N_ROPE);
#pragma unroll
        for (int bj = 0; bj < 2; ++bj) {
            const int c0 = u.pn * 256 + bj * 128 + wc * 32;
            bf16* dst = nullptr; float* fdst = nullptr; int ld = 0, cc = 0; bool rp = false; float scale = 1.f;
            if (c0 < C_KA) { dst = (bf16*)(ws + N_QA); ld = 512; cc = c0 - C_QA; rp = true; scale = C2; }
            else if (c0 < C_VA) { dst = (bf16*)(ws + N_KA); ld = 512; cc = c0 - C_KA; rp = true; }
            else if (c0 < C_QI) { dst = (bf16*)(ws + N_VA); ld = 512; cc = c0 - C_VA; }
            else if (c0 < C_KI) { dst = (bf16*)(ws + N_QI); ld = 256; cc = c0 - C_QI; rp = true; }
            else if (c0 < C_QB) { dst = (bf16*)(ws + N_KI); ld = 64; cc = c0 - C_KI; rp = true; }
            else if (c0 < C_FB) { dst = (bf16*)(ws + N_QB); ld = 256; cc = c0 - C_QB; }
            else if (c0 < C_IB) { fdst = (float*)(ws + N_FB); ld = 256; cc = c0 - C_FB; }
            else if (c0 < C_GB) { dst = (bf16*)(ws + N_IB); ld = 512; cc = c0 - C_IB; }
            else if (c0 < C_WI) { dst = (bf16*)(ws + N_GB); ld = 512; cc = c0 - C_GB; }
            else if (c0 == C_WI) {
                if (fq == 0) {
#pragma unroll
                    for (int ai = 0; ai < 2; ++ai)
#pragma unroll
                        for (int m = 0; m < 4; ++m) { const int row = row0 + ai * 128 + m * 16; const pg8::f32x4 v = acc[ai][bj][m][0] * 0.0625f; *(pg8::f32x4*)((float*)(ws + N_WI) + (size_t)row * 4) = v; }
                }
                continue;
            } else continue;
            rp = rp && ((cc & 32) == 0);
            const int col = cc + 8 * fq;
#pragma unroll
            for (int ai = 0; ai < 2; ++ai)
#pragma unroll
                for (int m = 0; m < 4; ++m) {
                    const int row = row0 + ai * 128 + m * 16;
                    pg8::f32x4 v0 = acc[ai][bj][m][0], v1 = acc[ai][bj][m][1];
                    if (rp) {
                        const pg8::f32x4 cs0 = *(const pg8::f32x4*)(rope + (size_t)row * 16), cs1 = *(const pg8::f32x4*)(rope + (size_t)row * 16 + 4);
                        const pg8::f32x4 sn0 = *(const pg8::f32x4*)(rope + (size_t)row * 16 + 8), sn1 = *(const pg8::f32x4*)(rope + (size_t)row * 16 + 12);
                        pg8::f32x4 o0, o1;
#pragma unroll
                        for (int j = 0; j < 4; ++j) { o0[j] = __shfl_xor(v0[j], 16); o1[j] = __shfl_xor(v1[j], 16); }
                        const float sg = (fq == 0) ? -1.f : 1.f;
                        if (fq < 2) { v0 = v0 * cs0 + o0 * sn0 * sg; v1 = v1 * cs1 + o1 * sn1 * sg; }
                    }
                    if (fdst) { float* p = fdst + (size_t)row * ld + col; *(pg8::f32x4*)p = v0; *(pg8::f32x4*)(p + 4) = v1; }
                    else {
                        v0 = v0 * scale; v1 = v1 * scale;
                        u32x4 w; w.x = pk2(v0[0], v0[1]); w.y = pk2(v0[2], v0[3]); w.z = pk2(v1[0], v1[1]); w.w = pk2(v1[2], v1[3]);
                        *(u32x4*)(dst + (size_t)row * ld + col) = w;
                    }
                }
        }
    }
};

struct TItem { const float* W; int ldw, scol0, nvalid; bf16* WT; size_t drow0; int kb; };
__device__ __forceinline__ void titem_issue(const TItem& it, int lane, float (&tv)[32]) {
    const int k0 = 64 * it.kb; const bool ok = (lane & 31) < it.nvalid;
#pragma unroll
    for (int i = 0; i < 32; ++i) { const int kk = 2 * i + (lane >> 5); tv[i] = __builtin_nontemporal_load(it.W + (size_t)(k0 + kk) * it.ldw + it.scol0 + (ok ? (lane & 31) : 0)); }
}
__device__ __forceinline__ void titem_finish(const TItem& it, int lane, const float (&tv)[32], LAS float* scr) {
    const int k0 = 64 * it.kb; const bool ok = (lane & 31) < it.nvalid;
#pragma unroll
    for (int i = 0; i < 32; ++i) { const int kk = 2 * i + (lane >> 5); scr[kk * 33 + (lane & 31)] = ok ? tv[i] : 0.f; }
    asm volatile("s_waitcnt lgkmcnt(0)" ::: "memory");
    const int c = lane & 7;
#pragma unroll
    for (int j = 0; j < 4; ++j) { const int n = (lane >> 3) + 8 * j; const LAS float* s = scr + (8 * c) * 33 + n;
        u32x4 o; o.x = pk2(s[0 * 33], s[1 * 33]); o.y = pk2(s[2 * 33], s[3 * 33]); o.z = pk2(s[4 * 33], s[5 * 33]); o.w = pk2(s[6 * 33], s[7 * 33]);
        __builtin_nontemporal_store(o, (u32x4*)(it.WT + (it.drow0 + n) * 1024 + k0 + 8 * c)); }
    asm volatile("s_waitcnt lgkmcnt(0)" ::: "memory");
}
#define TRANSPOSE_LOOP(first, stride, count, MK) do { \
    for (int r_ = (first); r_ < (count); r_ += 2 * (stride)) { \
        const bool two_ = r_ + (stride) < (count); \
        const TItem ia_ = MK(r_); const TItem ib_ = MK(two_ ? r_ + (stride) : r_); \
        float ta_[32], tb_[32]; \
        titem_issue(ia_, lane, ta_); if (two_) titem_issue(ib_, lane, tb_); \
        titem_finish(ia_, lane, ta_, scr); if (two_) titem_finish(ib_, lane, tb_, scr); } } while (0)

__device__ __forceinline__ void phase0(const Params& P, LAS unsigned char* lds, int vcu, int G, int wave, int lane) {
    unsigned char* ws = P.ws; const int tid = threadIdx.x;
    if (vcu < 96) {
        LAS float* sc = (LAS float*)lds;
        LAS float* red = (LAS float*)(lds + 16384);
        { float cv[8];
#pragma unroll
          for (int i = 0; i < 8; ++i) cv[i] = P.in[1][tid + i * NTHR];
#pragma unroll
          for (int i = 0; i < 8; ++i) sc[tid + i * NTHR] = cv[i] / (1.f + __expf(-cv[i])); }
        __syncthreads();
        const int col = vcu * 64 + lane; const float* aw = P.in[3];
        float a0 = 0.f, a1 = 0.f, a2 = 0.f, a3 = 0.f;
        for (int k0 = wave * 128; k0 < wave * 128 + 128; k0 += 32) {
            float w[32];
#pragma unroll
            for (int i = 0; i < 32; ++i) w[i] = __builtin_nontemporal_load(aw + (size_t)(k0 + i) * 6144 + col);
#pragma unroll
            for (int i = 0; i < 32; ++i) { const int k = k0 + i; a0 += sc[k] * w[i]; a1 += sc[1024 + k] * w[i]; a2 += sc[2048 + k] * w[i]; a3 += sc[3072 + k] * w[i]; }
        }
        red[(wave * 4 + 0) * 64 + lane] = a0; red[(wave * 4 + 1) * 64 + lane] = a1; red[(wave * 4 + 2) * 64 + lane] = a2; red[(wave * 4 + 3) * 64 + lane] = a3;
        __syncthreads();
        if (wave < 4) { float s = 0.f;
#pragma unroll
            for (int w = 0; w < 8; ++w) s += red[(w * 4 + wave) * 64 + lane];
            ((float*)(ws + N_MOD))[wave * 6144 + col] = s + P.in[4][col]; }
        __syncthreads();
    }
    PROBE_STAMP(P, 50);
    const bool split = G >= 192; const int wk = split ? vcu - 96 : vcu, nwk = split ? G - 96 : G;
    if (split && vcu < 96) return;
    { for (int gi = wk * NTHR + tid; gi < T * 8; gi += nwk * NTHR) { const int t = gi >> 3, i = gi & 7; const float invf = i == 0 ? 1.000000000e+00f : i == 1 ? 1.939227432e-01f : i == 2 ? 3.760603070e-02f : i == 3 ? 7.292664610e-03f : i == 4 ? 1.414213562e-03f : i == 5 ? 2.742481884e-04f : i == 6 ? 5.318295734e-05f : 1.031338525e-05f;     const float ang = (float)((const int*)P.in[2])[t] * invf;
          float* r = (float*)(ws + N_ROPE) + (size_t)t * 16; r[i] = (float)cos((double)ang); r[8 + i] = (float)sin((double)ang); }
      if (vcu == 255 && tid < 256) { const float l0 = P.in[8][tid], l1 = P.in[8][256 + tid]; const float m = fmaxf(l0, l1), e0 = __expf(l0 - m), e1 = __expf(l1 - m); ((float*)(ws + N_LB))[tid] = e0 / (e0 + e1); } }
    LAS float* scr = (LAS float*)(lds + 32768 + wave * 12288);
    const int gw = wk * NWAVES + wave, NGW = nwk * NWAVES;
    constexpr int I_IN = 16 * 112, I_OUT = 16 * 32;
    auto mk_in = [&](int r) { const int kb = r / 112, ng = r % 112; int scol = 0, nv = 32;
        if (ng < 58) scol = 32 * ng; else if (ng < 106) scol = 32 * ng + 4; else if (ng == 106) { scol = 1856; nv = 4; } else nv = 0;
        return TItem{P.in[6], DIN, scol, nv, (bf16*)(ws + N_WTIN), (size_t)32 * ng, kb}; };
    auto mk_out = [&](int r) { const int kb = r / 32, ng = r % 32; return TItem{P.in[9], 1024, 32 * ng, 32, (bf16*)(ws + N_WTOUT), (size_t)32 * ng, kb}; };
    TRANSPOSE_LOOP(gw, NGW, I_IN, mk_in);
    TRANSPOSE_LOOP(gw, NGW, I_OUT, mk_out);
}
template <int PART>
__device__ __forceinline__ void transpose_moe(const Params& P, LAS unsigned char* lds, int lo, int hi, int worker, int nworkers, int wave, int lane) {
    unsigned char* ws = P.ws;
    LAS float* scr = (LAS float*)(lds + 32768 + wave * 12288);
    if constexpr (PART == 0) {
        auto mk1 = [&](int r) { const int e = r >> 10, r2 = r & 1023, kb = r2 >> 6, ng = r2 & 63, pn = ng >> 3, within = ng & 7, half = within >> 2, off = (within & 3) * 32;
            return TItem{P.in[13] + (size_t)e * 1024 * 2048, 2048, half * 1024 + 128 * pn + off, 32, (bf16*)(ws + N_W1T), (size_t)e * 2048 + 32 * ng, kb}; };
        TRANSPOSE_LOOP(lo + worker, nworkers, hi, mk1);
    } else {
        auto mk2 = [&](int r) { const int e = r >> 9, r2 = r & 511, kb = r2 >> 5, ng = r2 & 31;
            return TItem{P.in[15] + (size_t)e * 1024 * 1024, 1024, 32 * ng, 32, (bf16*)(ws + N_W2T), (size_t)e * 1024 + 32 * ng, kb}; };
        TRANSPOSE_LOOP(lo + worker, nworkers, hi, mk2);
    }
}
constexpr int MOE_I_W1 = 32 * 16 * 64, MOE_I_W2 = 32 * 16 * 32;
__device__ __forceinline__ int moe_w1_early(int G) { return G == 256 ? 12288 : 0; }

__device__ __forceinline__ void phase1a(const Params& P, int vcu, int G, int wave, int lane) {
    const int gw = vcu * NWAVES + wave, NGW = G * NWAVES;
    const float* mod = (const float*)(P.ws + N_MOD);
    for (int r0 = gw * 8; r0 < T; r0 += NGW * 8) {
        const int b = r0 / S;
        const f32x4* xr = (const f32x4*)(P.in[0] + (size_t)r0 * D) + lane;
        f32x4 v[4][4];
#define LN_LOAD(slot, rr) do { _Pragma("unroll") for (int j = 0; j < 4; ++j) v[slot][j] = __builtin_nontemporal_load(xr + (rr) * 256 + 64 * j); } while (0)
#define LN_ROW(slot, rr) do { float ss = 0.f; \
            _Pragma("unroll") for (int j = 0; j < 4; ++j) ss += (v[slot][j].x * v[slot][j].x + v[slot][j].y * v[slot][j].y) + (v[slot][j].z * v[slot][j].z + v[slot][j].w * v[slot][j].w); \
            const float rstd = rsqrtf(wave_sum(ss) * (1.f / D) + 1e-6f); \
            u32x2* o8 = (u32x2*)((bf16*)(P.ws + N_HB) + (size_t)(r0 + (rr)) * D) + lane; \
            _Pragma("unroll") for (int j = 0; j < 4; ++j) { const f32x4 o = v[slot][j] * rstd * gs[j] + sh[j]; u32x2 q; q.x = pk2(o.x, o.y); q.y = pk2(o.z, o.w); o8[64 * j] = q; } } while (0)
        LN_LOAD(0, 0); LN_LOAD(1, 1); LN_LOAD(2, 2); LN_LOAD(3, 3);
        f32x4 gs[4], sh[4];
#pragma unroll
        for (int j = 0; j < 4; ++j) { const f32x4 g = ((const f32x4*)P.in[5])[lane + 64 * j], sc = ((const f32x4*)(mod + b * 6144 + 1024))[lane + 64 * j]; gs[j] = g * (sc + 1.f); sh[j] = ((const f32x4*)(mod + b * 6144))[lane + 64 * j]; }
        asm volatile("s_waitcnt vmcnt(8)" ::: "memory"); LN_ROW(0, 0); LN_ROW(1, 1); LN_LOAD(0, 4); LN_LOAD(1, 5);
        asm volatile("s_waitcnt vmcnt(16)" ::: "memory"); LN_ROW(2, 2); LN_ROW(3, 3); LN_LOAD(2, 6); LN_LOAD(3, 7);
        asm volatile("s_waitcnt vmcnt(16)" ::: "memory"); LN_ROW(0, 4); LN_ROW(1, 5);
        LN_ROW(2, 6); LN_ROW(3, 7);
#undef LN_LOAD
#undef LN_ROW
    }
}

}
namespace mk {
#define XB_TMO      128
#define XB_XCNT(j)  (256  + 64 * (j))
#define XB_XSUB(j)  (1280 + 64 * (j))
#define XB_XGEN(j)  (2304 + 64 * (j))
#define XB_TOP      3328
#define XB_TOPGEN   3392
#define XCD_BAR_WORDS 3456
#define XB_SPIN_CAP (1u << 18)

__device__ __forceinline__ unsigned xb_ld(unsigned* p)              { return __hip_atomic_load(p, __ATOMIC_RELAXED, __HIP_MEMORY_SCOPE_AGENT); }
__device__ __forceinline__ unsigned xb_add(unsigned* p, unsigned v) { return __hip_atomic_fetch_add(p, v, __ATOMIC_RELAXED, __HIP_MEMORY_SCOPE_AGENT); }
__device__ __forceinline__ unsigned xb_xcc_id() { return (unsigned)__builtin_amdgcn_s_getreg((3 << 11) | 20) & 0xFu; }
#define XB_SPIN(cond, bar) do { unsigned _sp = 0; while (cond) { __builtin_amdgcn_s_sleep(1); \
    if ((++_sp & 255u) == 0u) { if (xb_ld(&(bar)[XB_TMO])) break; if (_sp > XB_SPIN_CAP) { atomicAdd(&(bar)[XB_TMO], 1u); break; } } } } while (0)

struct XcdBarrier {
    unsigned* bar; unsigned x;
    volatile LAS unsigned* st;
};

__device__ __forceinline__ XcdBarrier xcd_barrier_post(unsigned* bar, volatile LAS unsigned* st) {
    XcdBarrier b; b.bar = bar; b.x = xb_xcc_id(); b.st = st;
    if (threadIdx.x == 0) (void)xb_add(&bar[XB_XCNT(b.x)], 1u);
    return b;
}
__device__ __forceinline__ void xcd_barrier_complete(unsigned* bar, unsigned x, unsigned& nloc, unsigned& nx) {
    const unsigned G = gridDim.x * gridDim.y * gridDim.z;
    unsigned sum, cnt, mine, sp = 0u;
    for (;;) {
        sum = 0u; cnt = 0u; mine = 0u;
#pragma unroll
        for (unsigned j = 0; j < 16; ++j) { const unsigned c = xb_ld(&bar[XB_XCNT(j)]); sum += c; cnt += (c > 0u) ? 1u : 0u; mine = (j == x) ? c : mine; }
        if (sum == G) break;
        __builtin_amdgcn_s_sleep(1);
        if ((++sp & 255u) == 0u) { if (xb_ld(&bar[XB_TMO])) break; if (sp > XB_SPIN_CAP) { atomicAdd(&bar[XB_TMO], 1u); break; } }
    }
    nloc = mine > 0u ? mine : 1u; nx = cnt > 0u ? cnt : 1u;
}

__device__ __forceinline__ void xcd_barrier(const XcdBarrier& b) {
    asm volatile("s_waitcnt vmcnt(0)" ::: "memory");
    __syncthreads();
    if (threadIdx.x == 0) {
        unsigned* bar = b.bar;
        __builtin_amdgcn_s_waitcnt(0);
        unsigned nloc = b.st[0], nx = b.st[1];
        if (nloc == 0u) { xcd_barrier_complete(bar, b.x, nloc, nx); b.st[0] = nloc; b.st[1] = nx; }
        const unsigned old = xb_add(&bar[XB_XSUB(b.x)], 1u);
        const unsigned gen = old / nloc;
        if (old + 1u == (gen + 1u) * nloc) {
            __builtin_amdgcn_fence(__ATOMIC_RELEASE, "agent");
            asm volatile("s_waitcnt vmcnt(0)" ::: "memory");
            const unsigned og = xb_add(&bar[XB_TOP], 1u);
            const unsigned tg = og / nx;
            if (og + 1u == (tg + 1u) * nx) xb_add(&bar[XB_TOPGEN], 1u);
            else XB_SPIN(xb_ld(&bar[XB_TOPGEN]) == tg, bar);
            __builtin_amdgcn_fence(__ATOMIC_ACQUIRE, "agent");
            xb_add(&bar[XB_XGEN(b.x)], 1u);
            asm volatile("s_waitcnt vmcnt(0)" ::: "memory");
        } else {
            XB_SPIN(xb_ld(&bar[XB_XGEN(b.x)]) == gen, bar);
            __builtin_amdgcn_fence(__ATOMIC_ACQUIRE, "agent");
            asm volatile("s_waitcnt vmcnt(0)" ::: "memory");
        }
    }
    __syncthreads();
}
}
namespace mk {
typedef short bf16x8 __attribute__((ext_vector_type(8)));
typedef float f32x16 __attribute__((ext_vector_type(16)));
typedef unsigned long long u64;
__device__ __forceinline__ int crow(int r, int hi) { return (r & 3) + 8 * (r >> 2) + 4 * hi; }

#define DPP_STEP(OP, v, ctrl, rmask) { const auto dpp_t_ = (decltype(v))__builtin_amdgcn_update_dpp((int)IDENT, (int)v, ctrl, rmask, 0xf, false); v = OP(v, dpp_t_); }
__device__ __forceinline__ int wave_sum_dpp(int v) {
    constexpr int IDENT = 0;
#define OPADD(a, b) ((a) + (b))
    DPP_STEP(OPADD, v, 0x111, 0xf); DPP_STEP(OPADD, v, 0x112, 0xf); DPP_STEP(OPADD, v, 0x114, 0xf); DPP_STEP(OPADD, v, 0x118, 0xf);
    DPP_STEP(OPADD, v, 0x142, 0xa); DPP_STEP(OPADD, v, 0x143, 0xc);
#undef OPADD
    return __builtin_amdgcn_readlane(v, 63);
}
__device__ __forceinline__ unsigned wave_min_dpp(unsigned v) {
    constexpr unsigned IDENT = 0xffffffffu;
#define OPMIN(a, b) __builtin_elementwise_min(a, b)
    DPP_STEP(OPMIN, v, 0x111, 0xf); DPP_STEP(OPMIN, v, 0x112, 0xf); DPP_STEP(OPMIN, v, 0x114, 0xf); DPP_STEP(OPMIN, v, 0x118, 0xf);
    DPP_STEP(OPMIN, v, 0x142, 0xa); DPP_STEP(OPMIN, v, 0x143, 0xc);
#undef OPMIN
    return (unsigned)__builtin_amdgcn_readlane((int)v, 63);
}
__device__ __forceinline__ unsigned wave_max_dpp(unsigned v) {
    constexpr unsigned IDENT = 0u;
#define OPMAX(a, b) __builtin_elementwise_max(a, b)
    DPP_STEP(OPMAX, v, 0x111, 0xf); DPP_STEP(OPMAX, v, 0x112, 0xf); DPP_STEP(OPMAX, v, 0x114, 0xf); DPP_STEP(OPMAX, v, 0x118, 0xf);
    DPP_STEP(OPMAX, v, 0x142, 0xa); DPP_STEP(OPMAX, v, 0x143, 0xc);
#undef OPMAX
    return (unsigned)__builtin_amdgcn_readlane((int)v, 63);
}
__device__ __forceinline__ void select_row(const float* srow, int nreg, int nwords, u64* mT, LAS unsigned* hist, int lane) {
    if (nreg <= 4) {
        for (int j = 0; j < nwords; ++j) if (lane == 0) { const u64 w = j < nreg ? ~0ull : 0ull; mT[(size_t)j * S] = w; }
        return;
    }
    unsigned key[64];
#pragma unroll
    for (int cq = 0; cq < 2; ++cq) {
        if (nreg > 32 * cq) {
            float f[32];
#pragma unroll
            for (int j = 0; j < 32; ++j) f[j] = __hip_atomic_load(srow + (32 * cq + j) * 64 + lane, __ATOMIC_RELAXED, __HIP_MEMORY_SCOPE_AGENT);
#pragma unroll
            for (int j = 0; j < 32; ++j) { const int u = __float_as_int(f[j] + 0.0f); const unsigned k = (unsigned)(u ^ ((u >> 31) | (int)0x80000000)); key[32 * cq + j] = k; }
        } else {
#pragma unroll
            for (int j = 0; j < 32; ++j) key[32 * cq + j] = 0u;
        }
    }
#define TSTAGE(OFF, J, M) _Pragma("unroll") for (int k_ = 0; k_ < 32; ++k_) if (!(k_ & J)) { const unsigned a_ = key[OFF + k_], b_ = key[OFF + k_ + J]; \
        key[OFF + k_] = (a_ & M) | ((b_ << J) & ~M); key[OFF + k_ + J] = ((a_ >> J) & M) | (b_ & ~M); }
    TSTAGE(0, 16, 0x0000ffffu) TSTAGE(0, 8, 0x00ff00ffu) TSTAGE(0, 4, 0x0f0f0f0fu) TSTAGE(0, 2, 0x33333333u) TSTAGE(0, 1, 0x55555555u)
    if (nreg > 32) { TSTAGE(32, 16, 0x0000ffffu) TSTAGE(32, 8, 0x00ff00ffu) TSTAGE(32, 4, 0x0f0f0f0fu) TSTAGE(32, 2, 0x33333333u) TSTAGE(32, 1, 0x55555555u) }
#undef TSTAGE
    unsigned alive0 = nreg >= 32 ? 0xffffffffu : ((1u << nreg) - 1u), alive1 = nreg > 32 ? (nreg >= 64 ? 0xffffffffu : ((1u << (nreg - 32)) - 1u)) : 0u;
    unsigned G0 = 0u, G1 = 0u; int g = 0; bool done = false;
#pragma unroll
    for (int bq = 31; bq >= 0; --bq) if (!done) {
        const unsigned a10 = alive0 & key[bq], a11 = alive1 & key[32 + bq];
        const int tot = wave_sum_dpp(__builtin_popcount(a10) + __builtin_popcount(a11));
        if (g + tot == 256) { G0 |= a10; G1 |= a11; alive0 = 0u; alive1 = 0u; done = true; }
        else if (g + tot > 256) { alive0 = a10; alive1 = a11; }
        else { G0 |= a10; G1 |= a11; g += tot; alive0 &= ~key[bq]; alive1 &= ~key[32 + bq]; }
    }
    if (!done) {
        const int need = 256 - g; int before = 0; const u64 lt = (1ull << lane) - 1ull;
#pragma unroll
        for (int j = 0; j < 64; ++j) if (j < nreg) {
            const bool eq = (((j < 32 ? alive0 : alive1) >> (j & 31)) & 1u) != 0u; const u64 em = __ballot(eq);
            const int myrank = before + __popcll(em & lt);
            if (eq && myrank < need) { if (j < 32) G0 |= 1u << (j & 31); else G1 |= 1u << (j & 31); }
            before += __popcll(em);
        }
    }
    { auto rr = __builtin_amdgcn_permlane32_swap(G0, G1, false, false); G0 = rr[0]; G1 = rr[1]; }
#define XSTAGE(d, m) { const unsigned q0 = (unsigned)__builtin_amdgcn_ds_swizzle((int)G0, ((d) << 10) | 0x1f), q1 = (unsigned)__builtin_amdgcn_ds_swizzle((int)G1, ((d) << 10) | 0x1f); \
        if (lane & (d)) { G0 = ((q0 >> (d)) & (m)) | (G0 & ~(m)); G1 = ((q1 >> (d)) & (m)) | (G1 & ~(m)); } \
        else { G0 = (G0 & (m)) | ((q0 << (d)) & ~(m)); G1 = (G1 & (m)) | ((q1 << (d)) & ~(m)); } }
    XSTAGE(16, 0x0000ffffu) XSTAGE(8, 0x00ff00ffu) XSTAGE(4, 0x0f0f0f0fu) XSTAGE(2, 0x33333333u) XSTAGE(1, 0x55555555u)
#undef XSTAGE
    if (lane < nwords) mT[(size_t)lane * S] = ((u64)G1 << 32) | G0;
}

__device__ __forceinline__ void phase_index(const Params& P, LAS unsigned char* lds, int vcu, int G, int wave, int lane, u64* mask_old) {
    unsigned char* ws = P.ws; const int tid = threadIdx.x, r32 = lane & 31, hi = lane >> 5;
    const bf16* QI = (const bf16*)(ws + N_QI); const bf16* KI = (const bf16*)(ws + N_KI); const float* WI = (const float*)(ws + N_WI);
    float* scb = (float*)(ws + N_SCORE) + (size_t)blockIdx.x * (32 * 4096);
    LAS float* wl = (LAS float*)lds;
    for (int pr = vcu; pr < 256; pr += G) {
        const int b = pr >> 6, p = pr & 63;
        for (int half = 0; half < 2; ++half) {
            const int g = half ? 127 - p : p;
            const int tl0 = 32 * g, nreg = g / 2 + 1, nwords = 4 * (tl0 / 256 + 1);
            const size_t t0 = (size_t)b * S + tl0;
            __syncthreads();
            if (nreg > 4) {
                if (tid < 128) wl[tid] = WI[t0 * 4 + tid];
                bf16x8 aq[4][4];
#pragma unroll
                for (int h = 0; h < 4; ++h)
#pragma unroll
                    for (int d0 = 0; d0 < 4; ++d0) aq[h][d0] = *(const bf16x8*)(QI + (t0 + r32) * 256 + h * 64 + d0 * 16 + hi * 8);
                bf16x8 bkn[4];
#pragma unroll
                for (int d0 = 0; d0 < 4; ++d0) bkn[d0] = *(const bf16x8*)(KI + ((size_t)b * S + 32 * wave + r32) * 64 + d0 * 16 + hi * 8);
                __syncthreads();
                for (int kt = wave; kt < 2 * nreg; kt += NWAVES) {
                    bf16x8 bk[4];
#pragma unroll
                    for (int d0 = 0; d0 < 4; ++d0) bk[d0] = bkn[d0];
                    if (kt + NWAVES < 2 * nreg) {
#pragma unroll
                        for (int d0 = 0; d0 < 4; ++d0) bkn[d0] = *(const bf16x8*)(KI + ((size_t)b * S + 32 * (kt + NWAVES) + r32) * 64 + d0 * 16 + hi * 8);
                    }
                    f32x16 sc = {};
#pragma unroll
                    for (int h = 0; h < 4; ++h) {
                        f32x16 a = {};
#pragma unroll
                        for (int d0 = 0; d0 < 4; ++d0) a = __builtin_amdgcn_mfma_f32_32x32x16_bf16(aq[h][d0], bk[d0], a, 0, 0, 0);
#pragma unroll
                        for (int r = 0; r < 16; ++r) { const float av_ = a[r]; const int ai_ = __float_as_int(av_); sc[r] += wl[crow(r, hi) * 4 + h] * __int_as_float(ai_ > 0 ? ai_ : 0); }
                        asm volatile("" : "+v"(sc));
                    }
                    {
                        LAS float* st = (LAS float*)(lds + 16384 + wave * 4608);
#pragma unroll
                        for (int r = 0; r < 16; ++r) st[crow(r, hi) * 36 + r32] = sc[r];
                        asm volatile("s_waitcnt lgkmcnt(0)" ::: "memory");
#pragma unroll
                        for (int i = 0; i < 4; ++i) { const int q = 8 * i + (lane >> 3), c4 = (lane & 7) * 4;
                            *(f32x4*)(scb + q * 4096 + 32 * kt + c4) = *(const LAS f32x4*)(st + q * 36 + c4); }
                        asm volatile("s_waitcnt lgkmcnt(0)" ::: "memory");
                    }
                }
                asm volatile("s_waitcnt vmcnt(0)" ::: "memory");
                __syncthreads();
            }
            for (int qq = 0; qq < 4; ++qq) {
                const int q = wave * 4 + qq; const int tl = tl0 + q;
                select_row(scb + q * 4096, nreg, nwords, (u64*)(ws + N_MASKT) + (size_t)b * 64 * S + tl, (LAS unsigned*)(lds + 1024) + wave * 256, lane);
            }
        }
    }
}
}
namespace mk {
typedef short s16x4 __attribute__((ext_vector_type(4)));
constexpr int AT_PITCH = 512;
constexpr int AT_SLOT = 18432, AT_K = 0, AT_V = 8192, AT_M = 16384, AT_WS = 3 * AT_SLOT, AT_OST = AT_WS + 8 * 512;
__device__ __forceinline__ void glds16(const void* gsrc, unsigned lds_dst) { unsigned keep;
    asm volatile("s_mov_b32 %0, m0\n\ts_mov_b32 m0, %2\n\ts_nop 0\n\tglobal_load_lds_dwordx4 %1, off\n\ts_mov_b32 m0, %0" : "=&s"(keep) : "v"(gsrc), "s"(lds_dst) : "memory"); }
__device__ __forceinline__ void glds4(const void* gsrc, unsigned lds_dst) { unsigned keep;
    asm volatile("s_mov_b32 %0, m0\n\ts_mov_b32 m0, %2\n\ts_nop 0\n\tglobal_load_lds_dword %1, off\n\ts_mov_b32 m0, %0" : "=&s"(keep) : "v"(gsrc), "s"(lds_dst) : "memory"); }
__device__ __forceinline__ float xhalf(float v) { return __shfl_xor(v, 32); }

__device__ __forceinline__ void attn_unit(const Params& P, LAS unsigned char* lds, int b, int h, int qb, int wave, int lane) {
    unsigned char* ws = P.ws; const int r32 = lane & 31, hi = lane >> 5;
    const bf16* QA = (const bf16*)(ws + N_QA); const bf16* KA = (const bf16*)(ws + N_KA); const bf16* VA = (const bf16*)(ws + N_VA);
    const u64* MT = (const u64*)(ws + N_MASKT) + (size_t)b * 64 * S;
    const size_t rowbase = (size_t)b * S; const int q0 = qb * 256, tq = q0 + wave * 32 + r32;
    const bf16* Kh = KA + rowbase * AT_PITCH + h * 64; const bf16* Vh = VA + rowbase * AT_PITCH + h * 64;
    const unsigned lds0 = (unsigned)(uintptr_t)lds;
    LAS float* wsf = (LAS float*)(lds + AT_WS) + wave * 128;
    const bf16* ksrc = Kh + (size_t)lane * AT_PITCH + wave * 8;
    const bf16* vsrc = Vh + (size_t)(16 * (wave & 3) + (lane >> 2)) * AT_PITCH + (wave >> 2) * 32 + (lane & 3) * 8;
    const unsigned kdst = lds0 + AT_K + wave * 1024, vdst = lds0 + AT_V + wave * 1024, mdst = lds0 + AT_M + wave * 256;
    const unsigned char* msrc = (const unsigned char*)(MT + q0) + wave * 256 + lane * 4;
    const int NT = 4 * (qb + 1);
    const int tlive = 4 * qb + (wave >> 1);
    bf16x8 qr[4];
#pragma unroll
    for (int d0 = 0; d0 < 4; ++d0) qr[d0] = *(const bf16x8*)(QA + (rowbase + tq) * AT_PITCH + h * 64 + d0 * 16 + hi * 8);
    float m = 0.f, mq = 0.f, l = 0.f; bool st = false;
    f32x16 o[2]; o[0] = f32x16{}; o[1] = f32x16{};
#define AT_ISSUE(tt, so) do { glds16(ksrc + (size_t)(tt) * 64 * AT_PITCH, (unsigned)__builtin_amdgcn_readfirstlane(kdst + (so))); \
                              glds16(vsrc + (size_t)(tt) * 64 * AT_PITCH, (unsigned)__builtin_amdgcn_readfirstlane(vdst + (so))); \
                              glds4(msrc + (size_t)(tt) * S * 8, (unsigned)__builtin_amdgcn_readfirstlane(mdst + (so))); } while (0)
    AT_ISSUE(0, 0); AT_ISSUE(1, AT_SLOT);
#define AT_QK(P0, P1, so) do { const LAS unsigned char* kb_ = lds + (so) + AT_K + hi * 1024 + r32 * 16; \
        { const u64 mw_ = *(const LAS u64*)(lds + (so) + AT_M + (wave * 32 + r32) * 8); const int lo_ = (int)((unsigned)mw_ >> (4 * hi)), hw_ = (int)((unsigned)(mw_ >> 32) >> (4 * hi)); \
          const int nm_ = __builtin_bit_cast(int, -m); mq = m; \
          _Pragma("unroll") for (int r = 0; r < 16; ++r) { const int cb = (r & 3) + 8 * (r >> 2); const int s0_ = __builtin_amdgcn_sbfe(lo_, cb, 1), s1_ = __builtin_amdgcn_sbfe(hw_, cb, 1); \
              P0[r] = __builtin_bit_cast(float, (s0_ & nm_) | (~s0_ & (int)0xff800000)); P1[r] = __builtin_bit_cast(float, (s1_ & nm_) | (~s1_ & (int)0xff800000)); } } \
        _Pragma("unroll") for (int d0 = 0; d0 < 4; ++d0) { \
            const bf16x8 b0_ = *(const LAS bf16x8*)(kb_ + d0 * 2048), b1_ = *(const LAS bf16x8*)(kb_ + d0 * 2048 + 512); \
            P0 = __builtin_amdgcn_mfma_f32_32x32x16_bf16(b0_, qr[d0], P0, 0, 0, 0); P1 = __builtin_amdgcn_mfma_f32_32x32x16_bf16(b1_, qr[d0], P1, 0, 0, 0); } } while (0)
    int slot = 0, slot1 = AT_SLOT, slot2 = 2 * AT_SLOT;
    asm volatile("s_waitcnt vmcnt(3)\n\ts_barrier" ::: "memory");
    f32x16 p0n, p1n;
    AT_QK(p0n, p1n, 0);
    for (int t = 0; t < NT; ++t) {
        f32x16 p0 = p0n, p1 = p1n; const float mqc = mq;
        if (t + 1 < NT) asm volatile("s_waitcnt vmcnt(0)\n\ts_barrier" ::: "memory");
        if (t + 2 < NT) AT_ISSUE(t + 2, slot2);
        if (t + 1 <= tlive) AT_QK(p0n, p1n, slot1);
        if (t <= tlive) {
        { const float dl = m - mqc;
          if (__any(dl != 0.f)) {
#pragma unroll
              for (int r = 0; r < 16; ++r) { p0[r] -= dl; p1[r] -= dl; } } }
        float rm, rm2;
        asm("v_max3_f32 %0, %1, %2, %3" : "=v"(rm) : "v"(p0[0]), "v"(p0[1]), "v"(p1[0]));
        asm("v_max3_f32 %0, %1, %2, %3" : "=v"(rm2) : "v"(p0[2]), "v"(p0[3]), "v"(p1[1]));
        asm("v_max3_f32 %0, %1, %2, %3" : "=v"(rm) : "v"(rm), "v"(p1[2]), "v"(p1[3]));
#pragma unroll
        for (int r = 4; r < 16; r += 4) {
            asm("v_max3_f32 %0, %1, %2, %3" : "=v"(rm) : "v"(rm), "v"(p0[r]), "v"(p0[r + 1]));
            asm("v_max3_f32 %0, %1, %2, %3" : "=v"(rm2) : "v"(rm2), "v"(p0[r + 2]), "v"(p0[r + 3]));
            asm("v_max3_f32 %0, %1, %2, %3" : "=v"(rm) : "v"(rm), "v"(p1[r]), "v"(p1[r + 1]));
            asm("v_max3_f32 %0, %1, %2, %3" : "=v"(rm2) : "v"(rm2), "v"(p1[r + 2]), "v"(p1[r + 3]));
        }
        rm = fmaxf(rm, rm2);
        { auto rr = __builtin_amdgcn_permlane32_swap(__float_as_uint(rm), __float_as_uint(rm), false, false); rm = fmaxf(__uint_as_float(rr[0]), __uint_as_float(rr[1])); }
        const bool has = rm > -INFINITY;
        if (__any((st && rm > 8.f) || (!st && has))) {
            const float sh = st ? (rm > 8.f ? rm : 0.f) : (has ? rm : 0.f);
            const float alpha = st ? __builtin_amdgcn_exp2f(-sh) : 1.f;
            if (hi == 0) wsf[r32] = alpha;
            asm volatile("s_waitcnt lgkmcnt(0)" ::: "memory");
#pragma unroll
            for (int r = 0; r < 16; ++r) { const float a = wsf[crow(r, hi)]; o[0][r] *= a; o[1][r] *= a; }
            l *= alpha; m += sh;
#pragma unroll
            for (int r = 0; r < 16; ++r) { p0[r] -= sh; p1[r] -= sh; }
        }
        st = st || has;
        pg8::f32x2 sac2 = {0.f, 0.f};
#pragma unroll
        for (int r = 0; r < 16; r += 2) { p0[r] = __builtin_amdgcn_exp2f(p0[r]); p0[r + 1] = __builtin_amdgcn_exp2f(p0[r + 1]); p1[r] = __builtin_amdgcn_exp2f(p1[r]); p1[r + 1] = __builtin_amdgcn_exp2f(p1[r + 1]);
            sac2 += (pg8::f32x2){p0[r], p0[r + 1]}; sac2 += (pg8::f32x2){p1[r], p1[r + 1]}; }
        l += sac2.x + sac2.y;
        u32x4 pw0, pw1, pw2, pw3;
        pw0 = (u32x4){pk2(p0[0], p0[1]), pk2(p0[2], p0[3]), pk2(p0[4], p0[5]), pk2(p0[6], p0[7])};
        pw1 = (u32x4){pk2(p0[8], p0[9]), pk2(p0[10], p0[11]), pk2(p0[12], p0[13]), pk2(p0[14], p0[15])};
        pw2 = (u32x4){pk2(p1[0], p1[1]), pk2(p1[2], p1[3]), pk2(p1[4], p1[5]), pk2(p1[6], p1[7])};
        pw3 = (u32x4){pk2(p1[8], p1[9]), pk2(p1[10], p1[11]), pk2(p1[12], p1[13]), pk2(p1[14], p1[15])};
        { const int vb = (int)(lds0 + slot + AT_V) + ((lane >> 4) & 1) * 32 + (lane & 3) * 8 + (4 * hi + ((lane & 15) >> 2)) * 64;
#pragma unroll
          for (int d0 = 0; d0 < 2; ++d0) { s16x4 vl[4], vh[4];
#pragma unroll
              for (int ks = 0; ks < 4; ++ks) {
                  asm volatile("ds_read_b64_tr_b16 %0,%1 offset:%c2" : "=&v"(vl[ks]) : "v"(vb), "i"(d0 * 4096 + ks * 1024) : "memory");
                  asm volatile("ds_read_b64_tr_b16 %0,%1 offset:%c2" : "=&v"(vh[ks]) : "v"(vb), "i"(d0 * 4096 + ks * 1024 + 512) : "memory"); }
              asm volatile("s_waitcnt lgkmcnt(0)" ::: "memory"); __builtin_amdgcn_sched_barrier(0);
#define PKV(k) (bf16x8){vl[k][0], vl[k][1], vl[k][2], vl[k][3], vh[k][0], vh[k][1], vh[k][2], vh[k][3]}
              o[d0] = __builtin_amdgcn_mfma_f32_32x32x16_bf16(__builtin_bit_cast(bf16x8, pw0), PKV(0), o[d0], 0, 0, 0);
              o[d0] = __builtin_amdgcn_mfma_f32_32x32x16_bf16(__builtin_bit_cast(bf16x8, pw1), PKV(1), o[d0], 0, 0, 0);
              o[d0] = __builtin_amdgcn_mfma_f32_32x32x16_bf16(__builtin_bit_cast(bf16x8, pw2), PKV(2), o[d0], 0, 0, 0);
              o[d0] = __builtin_amdgcn_mfma_f32_32x32x16_bf16(__builtin_bit_cast(bf16x8, pw3), PKV(3), o[d0], 0, 0, 0);
#undef PKV
          } }
        }
        { const int s_ = slot; slot = slot1; slot1 = slot2; slot2 = s_; }
    }
#undef AT_ISSUE
#undef AT_QK
    l += xhalf(l);
    if (hi == 0) wsf[32 + r32] = l;
    asm volatile("s_waitcnt lgkmcnt(0)" ::: "memory");
    { bf16* stg = (bf16*)((unsigned char*)nullptr); (void)stg; }
    LAS bf16* stg = (LAS bf16*)(lds + AT_OST) + wave * 2048;
#pragma unroll
    for (int r = 0; r < 16; ++r) { const int orow = crow(r, hi); const float rl = __builtin_amdgcn_rcpf(wsf[32 + orow]);
#pragma unroll
        for (int d0 = 0; d0 < 2; ++d0) stg[orow * 64 + d0 * 32 + r32] = (bf16)f2bf(o[d0][r] * rl); }
    asm volatile("s_waitcnt lgkmcnt(0)" ::: "memory");
    bf16* Ow = (bf16*)(ws + N_MIX) + (rowbase + q0 + wave * 32) * 1024 + h * 64;
#pragma unroll
    for (int i = 0; i < 4; ++i) { const int row = i * 8 + (lane >> 3), ch = lane & 7; const u32x4 v = *(const LAS u32x4*)(stg + row * 64 + ch * 8); *(u32x4*)(Ow + (size_t)row * 1024 + ch * 8) = v; }
    asm volatile("s_waitcnt lgkmcnt(0)" ::: "memory");
    __syncthreads();
}

__device__ __forceinline__ void phase_attn(const Params& P, LAS unsigned char* lds, int vcu, int G, int wave, int lane) {
    for (int pr = vcu; pr < 256; pr += G) {
        const int bh = pr >> 3, s = pr & 7, first = (pr & 8) ? 15 - s : s;
        attn_unit(P, lds, bh >> 3, bh & 7, first, wave, lane);
        PROBE_STAMP(P, 43);
        if (pr < G) { transpose_moe<0>(P, lds, moe_w1_early(G), MOE_I_W1, vcu * NWAVES + wave, G * NWAVES, wave, lane); transpose_moe<1>(P, lds, 0, MOE_I_W2, vcu * NWAVES + wave, G * NWAVES, wave, lane); __syncthreads(); }
        PROBE_STAMP(P, 44);
        attn_unit(P, lds, bh >> 3, bh & 7, 15 - first, wave, lane);
    }
}
}
namespace mk {
constexpr size_t N_BCNT = 64 * 1024;
constexpr size_t N_TOK = 1 * MiB + 256 * 1024;
constexpr int MOE_READY = 2048;
constexpr size_t N_ROWOF = 3 * MiB, N_RANK = 3 * MiB + 256 * 1024, N_GATE = 3 * MiB + 512 * 1024, N_TOPE = 3 * MiB + 768 * 1024;
constexpr size_t N_XS = 112 * MiB;
constexpr size_t N_ACT = 256 * MiB;
constexpr size_t N_Y = 658 * MiB;
constexpr size_t N_END_E = 802 * MiB;
constexpr int LDS_MISC = 131072;

struct EpiX1 {
    static constexpr bool PERM = false, AFTER_DRAIN = false; static constexpr int PID = 5;
    const float* x; const float* mod; float* x1;
    __device__ __forceinline__ void operator()(const pg8::f32x4 (&acc)[2][2][4][2], const pg8::Unit& u, int wr, int wc, int fr, int fq) const {
        const int row0 = u.pm * 256 + wr * 64 + fr, b = u.pm >> 4, col0 = u.pn * 256 + wc * 32 + 4 * fq;
        pg8::f32x4 g[2][2];
#pragma unroll
        for (int bj = 0; bj < 2; ++bj)
#pragma unroll
            for (int n = 0; n < 2; ++n) g[bj][n] = *(const pg8::f32x4*)(mod + b * 6144 + 2048 + col0 + bj * 128 + n * 16);
        pg8::f32x4 xa[2][2], xb[2][2], xc[2][2];
#define X1_OFF(st, n) ((size_t)(row0 + (((st) >> 2) & 1) * 128 + ((st) & 3) * 16) * 1024 + col0 + ((st) >> 3) * 128 + (n) * 16)
#define X1_LOAD(buf, s_) do { _Pragma("unroll") for (int q = 0; q < 2; ++q) _Pragma("unroll") for (int n = 0; n < 2; ++n) buf[q][n] = __builtin_nontemporal_load((const pg8::f32x4*)(x + X1_OFF(2 * (s_) + q, n))); \
        asm volatile("" ::: "memory"); } while (0)
#define X1_DO(buf, s_) do { _Pragma("unroll") for (int q = 0; q < 2; ++q) _Pragma("unroll") for (int n = 0; n < 2; ++n) { const int st = 2 * (s_) + q; \
        *(pg8::f32x4*)(x1 + X1_OFF(st, n)) = buf[q][n] + g[st >> 3][n] * acc[(st >> 2) & 1][st >> 3][st & 3][n]; } asm volatile("" ::: "memory"); } while (0)
        X1_LOAD(xa, 0); X1_LOAD(xb, 1); X1_LOAD(xc, 2); X1_DO(xa, 0); X1_LOAD(xa, 3); X1_DO(xb, 1); X1_LOAD(xb, 4); X1_DO(xc, 2); X1_LOAD(xc, 5);
        X1_DO(xa, 3); X1_LOAD(xa, 6); X1_DO(xb, 4); X1_LOAD(xb, 7); X1_DO(xc, 5); X1_DO(xa, 6); X1_DO(xb, 7);
#undef X1_OFF
#undef X1_LOAD
#undef X1_DO
    }
};
struct EpiSwiglu {
    static constexpr bool PERM = true, AFTER_DRAIN = false;
    const float* b1; bf16* act; int wt_rb;
    __device__ __forceinline__ void operator()(const pg8::f32x4 (&acc)[2][2][4][2], const pg8::Unit& u, int wr, int wc, int fr, int fq) const {
        const int e = u.pn >> 3, pnl = u.pn & 7, row0 = u.pm * 256 + wr * 64 + fr, colg = pnl * 128 + wc * 32 + 8 * fq;
        const float* bg = b1 + (size_t)e * 2048 + colg;
        const pg8::f32x4 bg0 = *(const pg8::f32x4*)bg, bg1 = *(const pg8::f32x4*)(bg + 4), bl0 = *(const pg8::f32x4*)(bg + 1024), bl1 = *(const pg8::f32x4*)(bg + 1028);
#pragma unroll
        for (int ai = 0; ai < 2; ++ai)
#pragma unroll
            for (int m = 0; m < 4; ++m) {
                const int row = row0 + ai * 128 + m * 16;
                const pg8::f32x4 g0 = acc[ai][0][m][0] + bg0, g1 = acc[ai][0][m][1] + bg1, l0 = acc[ai][1][m][0] + bl0, l1 = acc[ai][1][m][1] + bl1;
                unsigned ow[4];
#pragma unroll
                for (int p = 0; p < 4; ++p) { const int j = 2 * p;
                    pg8::f32x2 g = {j < 4 ? g0[j] : g1[j - 4], j < 4 ? g0[j + 1] : g1[j - 3]}, l = {j < 4 ? l0[j] : l1[j - 4], j < 4 ? l0[j + 1] : l1[j - 3]};
                    g.x = fminf(g.x, 7.f); g.y = fminf(g.y, 7.f); l.x = __builtin_amdgcn_fmed3f(l.x, -7.f, 7.f); l.y = __builtin_amdgcn_fmed3f(l.y, -7.f, 7.f);
                    const pg8::f32x2 t = g * (-1.702f * 1.44269504089f);
                    pg8::f32x2 d = {__builtin_amdgcn_exp2f(t.x), __builtin_amdgcn_exp2f(t.y)}; d = d + 1.f;
                    const pg8::f32x2 r = {__builtin_amdgcn_rcpf(d.x), __builtin_amdgcn_rcpf(d.y)};
                    const pg8::f32x2 o = (g * r) * (l + 1.f);
                    ow[p] = pk2(o.x, o.y); }
                u32x4 w; w.x = ow[0]; w.y = ow[1]; w.z = ow[2]; w.w = ow[3];
                bf16* dst = act + (size_t)row * 1024 + colg;
                if (u.pm < wt_rb) asm volatile("global_store_dwordx4 %0, %1, off sc1\n\ts_nop 1" :: "v"(dst), "v"(w) : "memory");
                else *(u32x4*)dst = w;
            }
    }
};
struct EpiY {
    static constexpr bool PERM = true, AFTER_DRAIN = false; static constexpr int PID = 9;
    const float* b2; bf16* y;
    __device__ __forceinline__ void operator()(const pg8::f32x4 (&acc)[2][2][4][2], const pg8::Unit& u, int wr, int wc, int fr, int fq) const {
        const int e = u.pn >> 2, pnl = u.pn & 3, row0 = u.pm * 256 + wr * 64 + fr;
#pragma unroll
        for (int bj = 0; bj < 2; ++bj) {
            const int col = pnl * 256 + bj * 128 + wc * 32 + 8 * fq;
            const pg8::f32x4 b0 = *(const pg8::f32x4*)(b2 + (size_t)e * 1024 + col), bb1 = *(const pg8::f32x4*)(b2 + (size_t)e * 1024 + col + 4);
#pragma unroll
            for (int ai = 0; ai < 2; ++ai)
#pragma unroll
                for (int m = 0; m < 4; ++m) {
                    const pg8::f32x4 v0 = acc[ai][bj][m][0] + b0, v1 = acc[ai][bj][m][1] + bb1;
                    u32x4 w; w.x = pk2(v0[0], v0[1]); w.y = pk2(v0[2], v0[3]); w.z = pk2(v1[0], v1[1]); w.w = pk2(v1[2], v1[3]);
                    *(u32x4*)(y + (size_t)(row0 + ai * 128 + m * 16) * 1024 + col) = w;
                }
        }
    }
};
struct EpiMoe {
    static constexpr bool PERM = true, AFTER_DRAIN = false; static constexpr int PID = 8;
    EpiSwiglu a; EpiY b;
    __device__ __forceinline__ void operator()(const pg8::f32x4 (&acc)[2][2][4][2], const pg8::Unit& u, int wr, int wc, int fr, int fq) const {
        if (u.pn < 256) a(acc, u, wr, wc, fr, fq);
        else { const pg8::Unit v{u.pm - NROWS / 256, u.pn - 256}; b(acc, v, wr, wc, fr, fq); }
    }
};
template <int NPN, bool GATHER_, bool EARLY>
struct MoeOrder {
    static constexpr bool GATHER = GATHER_;
    const LAS int* blke; int nunits, G, c; const int* tok; int mv; int* ready;
    __device__ __forceinline__ bool next(int i, pg8::Unit& u) const {
        int L = i * G + c; if (!EARLY) L += mv;
        if (L < nunits) { const int rb = L / NPN, pn = L % NPN; u.pm = rb; u.pn = blke[rb] * NPN + pn; return true; }
        if (EARLY && L - nunits < mv) { const int j = L - nunits, rb = j >> 2; u.pm = NROWS / 256 + rb; u.pn = 256 + blke[rb] * 4 + (j & 3); return true; }
        return false;
    }
    __device__ __forceinline__ void a_ready(const pg8::Unit& u) const {
        if (EARLY && u.pm >= NROWS / 256) {
            if (threadIdx.x < 64) {
                const int* rp = ready + (u.pm - NROWS / 256); unsigned spins = 0;
                while (__builtin_amdgcn_readfirstlane(__hip_atomic_load(rp, __ATOMIC_RELAXED, __HIP_MEMORY_SCOPE_AGENT)) < 64) { __builtin_amdgcn_s_sleep(2); if (++spins > (1u << 22)) break; }
                __builtin_amdgcn_fence(__ATOMIC_ACQUIRE, "agent");
                asm volatile("s_waitcnt vmcnt(0)" ::: "memory");
            }
            asm volatile("" ::: "memory"); __builtin_amdgcn_s_barrier(); asm volatile("" ::: "memory");
        }
    }
    __device__ __forceinline__ void done(const pg8::Unit& u) const {
        if (EARLY && u.pn < 256 && u.pm < ((mv + 3) >> 2)) {
            asm volatile("s_waitcnt vmcnt(0)" ::: "memory");
            if ((threadIdx.x & 63) == 0) __hip_atomic_fetch_add(ready + u.pm, 1, __ATOMIC_RELAXED, __HIP_MEMORY_SCOPE_AGENT);
        }
    }
};
__device__ __forceinline__ int moe_tables(const int* cnt, LAS int* ps, LAS int* blke) {
    __syncthreads();
    if (threadIdx.x < 64) {
        const int l = threadIdx.x & 31; const int v = (__hip_atomic_load(cnt + l, __ATOMIC_RELAXED, __HIP_MEMORY_SCOPE_AGENT) + 255) / 256 * 256; int inc = v;
#pragma unroll
        for (int d = 1; d < 32; d <<= 1) { const int o = __shfl_up(inc, d, 32); if (l >= d) inc += o; }
        if (threadIdx.x < 32) { ps[l] = inc - v; if (l == 31) ps[32] = inc;
            for (int rb = (inc - v) >> 8; rb < (inc >> 8); ++rb) blke[rb] = l; } }
    __syncthreads();
    return ps[32] >> 8;
}

__device__ __forceinline__ void route_fill(const Params& P, LAS unsigned char* lds) {
    const int tid = threadIdx.x; LAS float* rwl = (LAS float*)lds; LAS int* lcnt = (LAS int*)(lds + 147456);
    {
        f32x4 wv[16];
#pragma unroll
        for (int i = 0; i < 16; ++i) wv[i] = ((const f32x4*)P.in[11])[tid + i * NTHR];
#pragma unroll
        for (int i = 0; i < 16; ++i) { const int idx = tid + i * NTHR; *(LAS f32x4*)(rwl + (idx >> 5) * 132 + ((idx >> 3) & 3) * 32 + (idx & 7) * 4) = wv[i]; }
    }
    if (tid < 32) lcnt[tid] = 0;
}
__device__ __forceinline__ void phase_route(const Params& P, LAS unsigned char* lds, int vcu, int G, int wave, int lane) {
    unsigned char* ws = P.ws; const int tid = threadIdx.x;
    LAS float* rwl = (LAS float*)lds;
    LAS int* lcnt = (LAS int*)(lds + 147456);
    const float* mod = (const float*)(ws + N_MOD); const float* X1 = (const float*)(ws + N_X1);
    const int gw = vcu * NWAVES + wave, NGW = G * NWAVES;
    f32x4 gsv[4], shv[4], vn[2][4];
#define RT_ISSUE(r8_) do { const int b_ = (r8_) / S; \
        _Pragma("unroll") for (int m = 0; m < 4; ++m) { const int k4 = lane + 64 * m; gsv[m] = ((const f32x4*)P.in[10])[k4] * (((const f32x4*)(mod + b_ * 6144 + 4096))[k4] + 1.f); shv[m] = ((const f32x4*)(mod + b_ * 6144 + 3072))[k4]; } \
        _Pragma("unroll") for (int m = 0; m < 4; ++m) { vn[0][m] = ((const f32x4*)(X1 + (size_t)(r8_) * D))[lane + 64 * m]; vn[1][m] = ((const f32x4*)(X1 + (size_t)((r8_) + 1) * D))[lane + 64 * m]; } } while (0)
    if (gw * 8 < T) RT_ISSUE(gw * 8);
    __syncthreads();
    const float rbias = P.in[12][lane >> 1];
    for (int r8 = gw * 8; r8 < T; r8 += NGW * 8) {
    if (r8 != gw * 8) RT_ISSUE(r8);
#pragma unroll 1
    for (int pp = 0; pp < 4; ++pp) {
        const int r0 = r8 + 2 * pp;
        f32x4 hv[2][4];
        {
            f32x4 v[2][4]; float ss0 = 0.f, ss1 = 0.f;
#pragma unroll
            for (int m = 0; m < 4; ++m) { v[0][m] = vn[0][m]; v[1][m] = vn[1][m];
                ss0 += (v[0][m].x * v[0][m].x + v[0][m].y * v[0][m].y) + (v[0][m].z * v[0][m].z + v[0][m].w * v[0][m].w);
                ss1 += (v[1][m].x * v[1][m].x + v[1][m].y * v[1][m].y) + (v[1][m].z * v[1][m].z + v[1][m].w * v[1][m].w); }
            if (pp < 3) {
#pragma unroll
                for (int m = 0; m < 4; ++m) { vn[0][m] = ((const f32x4*)(X1 + (size_t)(r0 + 2) * D))[lane + 64 * m]; vn[1][m] = ((const f32x4*)(X1 + (size_t)(r0 + 3) * D))[lane + 64 * m]; }
            }
            const float rs0 = rsqrtf(wave_sum(ss0) * (1.f / D) + 1e-6f), rs1 = rsqrtf(wave_sum(ss1) * (1.f / D) + 1e-6f);
#pragma unroll
            for (int m = 0; m < 4; ++m) { const int k4 = lane + 64 * m;
                hv[0][m] = v[0][m] * rs0 * gsv[m] + shv[m]; hv[1][m] = v[1][m] * rs1 * gsv[m] + shv[m];
                u32x2 q0, q1; q0.x = pk2(hv[0][m].x, hv[0][m].y); q0.y = pk2(hv[0][m].z, hv[0][m].w); q1.x = pk2(hv[1][m].x, hv[1][m].y); q1.y = pk2(hv[1][m].z, hv[1][m].w);
                ((u32x2*)((bf16*)(ws + N_HB) + (size_t)r0 * D))[k4] = q0; ((u32x2*)((bf16*)(ws + N_HB) + (size_t)(r0 + 1) * D))[k4] = q1; }
        }
        float a0[32], a1[32];
        {
            typedef float f32x2p __attribute__((ext_vector_type(2)));
            f32x2p ac[32];
#pragma unroll
            for (int e = 0; e < 32; ++e) ac[e] = (f32x2p){0.f, 0.f};
            const unsigned wb0 = (unsigned)(uintptr_t)rwl + (unsigned)lane * 528u;
            f32x4 wA[4], wB[4];
#define RW_LOAD(buf, hs) do { const unsigned ad_ = wb0 + ((hs) >> 3) * 33792u; _Pragma("unroll") for (int i = 0; i < 4; ++i) \
                asm volatile("ds_read_b128 %0, %1 offset:%c2" : "=&v"(buf[i]) : "v"(ad_), "i"((((hs) >> 1) & 3) * 128 + ((hs) & 1) * 64 + i * 16) : "memory"); } while (0)
#define RW_FMA(buf, hs) do { const f32x2p h2 = {hv[0][(hs) >> 3][((hs) >> 1) & 3], hv[1][(hs) >> 3][((hs) >> 1) & 3]}; _Pragma("unroll") for (int i = 0; i < 4; ++i) _Pragma("unroll") for (int c = 0; c < 4; ++c) \
                ac[16 * ((hs) & 1) + 4 * i + c] = __builtin_elementwise_fma(h2, (f32x2p){buf[i][c], buf[i][c]}, ac[16 * ((hs) & 1) + 4 * i + c]); } while (0)
#define RW_STEP(cur, nxt, hs) do { if ((hs) < 31) { RW_LOAD(nxt, (hs) + 1); asm volatile("s_waitcnt lgkmcnt(4)" ::: "memory"); } else asm volatile("s_waitcnt lgkmcnt(0)" ::: "memory"); \
                __builtin_amdgcn_sched_barrier(0); RW_FMA(cur, hs); } while (0)
#define RW_STEP4(h0) RW_STEP(wA, wB, h0); RW_STEP(wB, wA, (h0) + 1); RW_STEP(wA, wB, (h0) + 2); RW_STEP(wB, wA, (h0) + 3)
            RW_LOAD(wA, 0);
            RW_STEP4(0); RW_STEP4(4); RW_STEP4(8); RW_STEP4(12); RW_STEP4(16); RW_STEP4(20); RW_STEP4(24); RW_STEP4(28);
#undef RW_STEP4
#undef RW_LOAD
#undef RW_FMA
#undef RW_STEP
#pragma unroll
            for (int e = 0; e < 32; ++e) { a0[e] = ac[e].x; a1[e] = ac[e].y; }
        }
#define TRED(W, N) { const bool up = (lane & W) != 0; _Pragma("unroll") for (int e = 0; e < N; ++e) { \
            const float k0 = up ? a0[e + N] : a0[e], s0 = up ? a0[e] : a0[e + N]; a0[e] = k0 + __shfl_xor(s0, W); \
            const float k1 = up ? a1[e + N] : a1[e], s1 = up ? a1[e] : a1[e + N]; a1[e] = k1 + __shfl_xor(s1, W); } }
        TRED(32, 16) TRED(16, 8) TRED(8, 4) TRED(4, 2) TRED(2, 1)
#undef TRED
        a0[0] += __shfl_xor(a0[0], 1); a1[0] += __shfl_xor(a1[0], 1);
#pragma unroll
        for (int r = 0; r < 2; ++r) {
            const float logit = (r ? a1[0] : a0[0]) + rbias; const int e = lane >> 1;
            const unsigned u = __float_as_uint(logit + 0.0f); const unsigned mono = (u & 0x80000000u) ? ~u : (u | 0x80000000u);
            unsigned key = mono;
            float tv[4]; int te[4];
#pragma unroll
            for (int k = 0; k < 4; ++k) {
                const unsigned mx = wave_max_dpp(key);
                const int L = __ffsll((long long)__ballot(key == mx)) - 1;
                te[k] = L >> 1; tv[k] = __builtin_bit_cast(float, __builtin_amdgcn_readlane(__builtin_bit_cast(int, logit), L));
                if (e == te[k]) key = 0u;
            }
            const float p1 = __expf(tv[1] - tv[0]), p2 = __expf(tv[2] - tv[0]), p3 = __expf(tv[3] - tv[0]); const float inv = 1.f / (1.f + p1 + p2 + p3);
            if (lane < 4) { const int t = r0 + r; const int ee = lane == 0 ? te[0] : lane == 1 ? te[1] : lane == 2 ? te[2] : te[3]; const float gg = (lane == 0 ? 1.f : lane == 1 ? p1 : lane == 2 ? p2 : p3) * inv;
                ((int*)(ws + N_TOPE))[t * 4 + lane] = ee; ((float*)(ws + N_GATE))[t * 4 + lane] = gg; ((int*)(ws + N_RANK))[t * 4 + lane] = (vcu << 16) | __hip_atomic_fetch_add(lcnt + ee, 1, __ATOMIC_RELAXED, __HIP_MEMORY_SCOPE_WORKGROUP); }
        }
    }
    }
    __syncthreads();
    if (tid < 32) ((int*)(ws + N_BCNT))[vcu * 32 + tid] = lcnt[tid];
}
__device__ __forceinline__ void phase_scatter(const Params& P, LAS unsigned char* lds, int vcu, int G, int wave, int lane) {
    unsigned char* ws = P.ws; const int tid = threadIdx.x;
    LAS int* ps = (LAS int*)(lds + LDS_MISC); LAS int* base = (LAS int*)lds;
    const int* bc = (const int*)(ws + N_BCNT);
    __syncthreads();
    if (G == 256) { int bv[16];
#pragma unroll
        for (int i = 0; i < 16; ++i) bv[i] = bc[tid + i * NTHR];
#pragma unroll
        for (int i = 0; i < 16; ++i) base[tid + i * NTHR] = bv[i];
    } else for (int i = tid; i < G * 32; i += NTHR) base[i] = bc[i];
    __syncthreads();
    if (G == 256) {
        LAS int* seg = ps + 128; const int e = tid & 31, sg = tid >> 5; int sum = 0;
#pragma unroll
        for (int k = 0; k < 16; ++k) sum += base[(sg * 16 + k) * 32 + e];
        seg[sg * 32 + e] = sum;
        __syncthreads();
        int a = 0;
        for (int s2 = 0; s2 < sg; ++s2) a += seg[s2 * 32 + e];
        if (sg == 15) ps[40 + e] = a + sum;
#pragma unroll
        for (int k = 0; k < 16; ++k) { const int v = base[(sg * 16 + k) * 32 + e]; base[(sg * 16 + k) * 32 + e] = a; a += v; }
    } else if (tid < 32) { int a = 0; for (int k = 0; k < G; ++k) { const int v = base[k * 32 + tid]; base[k * 32 + tid] = a; a += v; } ps[40 + tid] = a; }
    __syncthreads();
    if (tid < 64) { const int l = tid & 31; const int v = (ps[40 + l] + 255) / 256 * 256; int inc = v;
#pragma unroll
        for (int d = 1; d < 32; d <<= 1) { const int o = __shfl_up(inc, d, 32); if (l >= d) inc += o; }
        if (tid < 32) { ps[l] = inc - v; if (l == 31) ps[32] = inc; } }
    __syncthreads();
    if (blockIdx.x == 0 && tid < 32) ((int*)ctl())[tid] = ps[40 + tid];
    const int gw = vcu * NWAVES + wave, NGW = G * NWAVES;
    int* tok = (int*)(ws + N_TOK);
    for (int i = vcu * NTHR + tid; i < T * 4; i += G * NTHR) {
        const int e = ((const int*)(ws + N_TOPE))[i], rk = ((const int*)(ws + N_RANK))[i];
        const int row = ps[e] + base[(rk >> 16) * 32 + e] + (rk & 0xffff);
        ((int*)(ws + N_ROWOF))[i] = row; tok[row] = i >> 2;
    }
    for (int e = vcu; e < 32; e += G) { const int r0 = ps[e] + ps[40 + e], r1 = ps[e + 1]; for (int r = r0 + tid; r < r1; r += NTHR) tok[r] = 0; }
    for (int i = vcu * NTHR + tid; i < NROWS; i += G * NTHR) tok[NROWS + i] = (int)((N_ACT - N_HB) / 2048) + i;
}
__device__ __forceinline__ void final_pair(const Params& P, const float* mod, int t, int lane) {
    unsigned char* ws = P.ws; const int b = t / S;
    f32x4 acc[2][4]; u32x2 yv[2][4][4]; float gk[2][4];
#pragma unroll
    for (int r = 0; r < 2; ++r)
#pragma unroll
        for (int k = 0; k < 4; ++k) {
            gk[r][k] = ((const float*)(ws + N_GATE))[(t + r) * 4 + k]; const int row = ((const int*)(ws + N_ROWOF))[(t + r) * 4 + k];
            const u32x2* yr = (const u32x2*)((const bf16*)(ws + N_Y) + (size_t)row * D) + lane;
#pragma unroll
            for (int j = 0; j < 4; ++j) yv[r][k][j] = yr[64 * j];
        }
    f32x4 xv[2][4];
#pragma unroll
    for (int r = 0; r < 2; ++r)
#pragma unroll
        for (int j = 0; j < 4; ++j) xv[r][j] = ((const f32x4*)((const float*)(ws + N_X1) + (size_t)(t + r) * D))[lane + 64 * j];
#pragma unroll
    for (int r = 0; r < 2; ++r) {
#pragma unroll
        for (int j = 0; j < 4; ++j) acc[r][j] = (f32x4){0.f, 0.f, 0.f, 0.f};
#pragma unroll
        for (int k = 0; k < 4; ++k)
#pragma unroll
            for (int j = 0; j < 4; ++j) { const u32x2 w = yv[r][k][j]; const float g = gk[r][k];
                acc[r][j].x += g * __builtin_bit_cast(float, w.x << 16); acc[r][j].y += g * __builtin_bit_cast(float, w.x & 0xffff0000u);
                acc[r][j].z += g * __builtin_bit_cast(float, w.y << 16); acc[r][j].w += g * __builtin_bit_cast(float, w.y & 0xffff0000u); }
        f32x4 v[4]; float ss = 0.f;
#pragma unroll
        for (int j = 0; j < 4; ++j) { const f32x4 g2 = ((const f32x4*)(mod + b * 6144 + 5120))[lane + 64 * j];
            v[j] = xv[r][j] + g2 * acc[r][j]; ss += (v[j].x * v[j].x + v[j].y * v[j].y) + (v[j].z * v[j].z + v[j].w * v[j].w); }
        const float rstd = rsqrtf(wave_sum(ss) * (1.f / D) + 1e-6f);
#pragma unroll
        for (int j = 0; j < 4; ++j) ((f32x4*)(P.out + (size_t)(t + r) * D))[lane + 64 * j] = v[j] * rstd * ((const f32x4*)P.in[17])[lane + 64 * j];
    }
}
__device__ __forceinline__ void phase_final(const Params& P, int vcu, int G, int wave, int lane) {
    unsigned char* ws = P.ws; const float* mod = (const float*)(ws + N_MOD);
    const int gw = vcu * NWAVES + wave, NGW = G * NWAVES;
    for (int t0 = gw * 8; t0 < T; t0 += NGW * 8) {
        const int b = t0 / S;
        const int ro = ((const int*)(ws + N_ROWOF))[t0 * 4 + (lane & 31)]; const float gt = ((const float*)(ws + N_GATE))[t0 * 4 + (lane & 31)];
        f32x4 g2[4], wf[4];
#pragma unroll
        for (int j = 0; j < 4; ++j) { g2[j] = ((const f32x4*)(mod + b * 6144 + 5120))[lane + 64 * j]; wf[j] = ((const f32x4*)P.in[17])[lane + 64 * j]; }
        u32x2 yA[4][4], yB[4][4]; f32x4 xA[4], xB[4];
#define FN_LOAD(Y, X, r) do { _Pragma("unroll") for (int j = 0; j < 4; ++j) X[j] = __builtin_nontemporal_load((const f32x4*)((const float*)(ws + N_X1) + (size_t)(t0 + (r)) * D) + lane + 64 * j); \
            _Pragma("unroll") for (int k = 0; k < 4; ++k) { const int row = __builtin_amdgcn_readlane(ro, (r) * 4 + k); \
            const u32x2* yr = (const u32x2*)((const bf16*)(ws + N_Y) + (size_t)row * D) + lane; _Pragma("unroll") for (int j = 0; j < 4; ++j) Y[k][j] = __builtin_nontemporal_load(yr + 64 * j); } \
            asm volatile("" ::: "memory"); } while (0)
#define FN_ROW(Y, X, r) do { f32x4 v[4]; float ss = 0.f; \
            _Pragma("unroll") for (int j = 0; j < 4; ++j) { f32x4 acc = (f32x4){0.f, 0.f, 0.f, 0.f}; \
                _Pragma("unroll") for (int k = 0; k < 4; ++k) { const u32x2 w = Y[k][j]; const float g = __builtin_bit_cast(float, __builtin_amdgcn_readlane(__builtin_bit_cast(int, gt), (r) * 4 + k)); \
                    acc.x += g * __builtin_bit_cast(float, w.x << 16); acc.y += g * __builtin_bit_cast(float, w.x & 0xffff0000u); \
                    acc.z += g * __builtin_bit_cast(float, w.y << 16); acc.w += g * __builtin_bit_cast(float, w.y & 0xffff0000u); } \
                v[j] = X[j] + g2[j] * acc; ss += (v[j].x * v[j].x + v[j].y * v[j].y) + (v[j].z * v[j].z + v[j].w * v[j].w); } \
            const float rstd = rsqrtf(wave_sum(ss) * (1.f / D) + 1e-6f); \
            _Pragma("unroll") for (int j = 0; j < 4; ++j) __builtin_nontemporal_store(v[j] * rstd * wf[j], (f32x4*)(P.out + (size_t)(t0 + (r)) * D) + lane + 64 * j); } while (0)
        FN_LOAD(yA, xA, 0);
#pragma unroll 1
        for (int r = 0; r < 8; r += 2) { FN_LOAD(yB, xB, r + 1); FN_ROW(yA, xA, r); if (r + 2 < 8) FN_LOAD(yA, xA, r + 2); FN_ROW(yB, xB, r + 1); }
#undef FN_LOAD
#undef FN_ROW
    }
}
}
namespace mk {
constexpr size_t N_HGB = 802 * MiB;
constexpr size_t HG_UT = N_HGB;
constexpr size_t HG_OI = N_HGB + 32 * MiB;
constexpr size_t HG_QT = N_HGB + 64 * MiB;
constexpr size_t HG_DEC = N_HGB + 72 * MiB;
constexpr size_t HG_ST = N_HGB + 73 * MiB;
constexpr size_t N_END_D = N_HGB + 89 * MiB;
constexpr int HG_FLAG = 1024;
constexpr int H_LB = 0, H_TOT = 16384, H_QS = 18432, H_KS = H_QS + 9216, H_KT = H_KS + 4 * 9216, H_VT = H_KT + 9216, H_AM = H_VT + 18432, H_END = H_AM + 9216;
typedef float f32x4v __attribute__((ext_vector_type(4)));
#define MFMA16(a, b, c) __builtin_amdgcn_mfma_f32_16x16x32_bf16(a, b, c, 0, 0, 0)

__device__ __forceinline__ void hgrn_local_unit(const Params& P, LAS unsigned char* lds, int u, int wave, int lane) {
    unsigned char* ws = P.ws; const int tid = threadIdx.x;
    const int bh = u >> 6, c = u & 63, b = bh >> 2, h = bh & 3;
    const size_t row0 = (size_t)b * S + c * 64;
    LAS float* LB = (LAS float*)(lds + H_LB); LAS float* TOT = (LAS float*)(lds + H_TOT);
    LAS bf16* QS = (LAS bf16*)(lds + H_QS); LAS bf16* KS = (LAS bf16*)(lds + H_KS); LAS bf16* KT = (LAS bf16*)(lds + H_KT); LAS bf16* VT = (LAS bf16*)(lds + H_VT); LAS bf16* AM = (LAS bf16*)(lds + H_AM);
    const int t = tid >> 3, d0 = (tid & 7) * 8;
    float qf[8], kf[8], bc[8];
    {
        const float* fbp = (const float*)(ws + N_FB) + (row0 + t) * 256 + h * 64 + d0; const float* lbp = (const float*)(ws + N_LB) + h * 64 + d0;
        const f32x4 f0 = *(const f32x4*)fbp, f1 = *(const f32x4*)(fbp + 4), l0 = *(const f32x4*)lbp, l1 = *(const f32x4*)(lbp + 4);
        const u32x4 qv = *(const u32x4*)((const bf16*)(ws + N_QB) + (row0 + t) * 256 + h * 64 + d0);
#pragma unroll
        for (int j = 0; j < 8; ++j) {
            const float fb = j < 4 ? f0[j] : f1[j - 4], lb = j < 4 ? l0[j] : l1[j - 4];
            const float sg = 1.f / (1.f + __expf(-fb));
            const float f = lb + (1.f - lb) * sg;
            bc[j] = __logf(f); kf[j] = (1.f - lb) * (1.f - sg);
            const unsigned w = qv[j >> 1]; qf[j] = __builtin_bit_cast(float, (j & 1) ? (w & 0xffff0000u) : (w << 16));
            LB[t * 64 + d0 + j] = bc[j];
        }
    }
    for (int i = tid; i < 576; i += NTHR) ((LAS u32x4*)AM)[i] = (u32x4){0u, 0u, 0u, 0u};
#pragma unroll
    for (int i = 0; i < 2; ++i) { const int id = tid + 512 * i, s = id >> 4, e0 = (id & 15) * 8;
        const u32x4 v = *(const u32x4*)((const bf16*)(ws + N_IB) + (row0 + s) * 512 + h * 128 + e0);
#pragma unroll
        for (int j = 0; j < 8; ++j) VT[(e0 + j) * 72 + s] = (bf16)((j & 1) ? (v[j >> 1] >> 16) : (v[j >> 1] & 0xffffu)); }
    __syncthreads();
    { float a = 0.f;
#pragma unroll
      for (int r = 0; r < 8; ++r) { a += LB[(wave * 8 + r) * 64 + lane]; LB[(wave * 8 + r) * 64 + lane] = a; } }
    __syncthreads();
    if (wave == 0) { float a = 0.f;
#pragma unroll
        for (int g = 0; g < 8; ++g) { TOT[g * 64 + lane] = a; a += LB[(g * 8 + 7) * 64 + lane]; } }
    __syncthreads();
#pragma unroll
    for (int j = 0; j < 8; ++j) bc[j] = LB[t * 64 + d0 + j] + TOT[(t >> 3) * 64 + d0 + j];
    __syncthreads();
#pragma unroll
    for (int j = 0; j < 8; ++j) LB[t * 64 + d0 + j] = bc[j];
    __syncthreads();
    {
        const int I = t >> 4;
        float rI[8], bl[8];
#pragma unroll
        for (int j = 0; j < 8; ++j) { rI[j] = I ? LB[(16 * I - 1) * 64 + d0 + j] : 0.f; bl[j] = LB[63 * 64 + d0 + j]; }
        unsigned pq[4], pt[4];
#pragma unroll
        for (int j = 0; j < 8; j += 2) { pq[j >> 1] = pk2(qf[j] * __expf(bc[j] - rI[j]), qf[j + 1] * __expf(bc[j + 1] - rI[j + 1])); pt[j >> 1] = pk2(qf[j] * __expf(bc[j]), qf[j + 1] * __expf(bc[j + 1])); }
        *(LAS u32x4*)(QS + t * 72 + d0) = (u32x4){pq[0], pq[1], pq[2], pq[3]};
        *(u32x4*)((bf16*)(ws + HG_QT) + ((size_t)u * 64 + t) * 64 + d0) = (u32x4){pt[0], pt[1], pt[2], pt[3]};
#pragma unroll
        for (int I2 = 0; I2 < 4; ++I2) if (I2 >= I) {
            unsigned pk[4];
#pragma unroll
            for (int j = 0; j < 8; j += 2) { const float r0 = I2 ? LB[(16 * I2 - 1) * 64 + d0 + j] : 0.f, r1 = I2 ? LB[(16 * I2 - 1) * 64 + d0 + j + 1] : 0.f;
                pk[j >> 1] = pk2(kf[j] * __expf(r0 - bc[j]), kf[j + 1] * __expf(r1 - bc[j + 1])); }
            *(LAS u32x4*)(KS + I2 * 4608 + t * 72 + d0) = (u32x4){pk[0], pk[1], pk[2], pk[3]};
        }
#pragma unroll
        for (int j = 0; j < 8; ++j) KT[(d0 + j) * 72 + t] = (bf16)f2bf(kf[j] * __expf(bl[j] - bc[j]));
        if (t == 63) {
#pragma unroll
            for (int j = 0; j < 8; ++j) ((float*)(ws + HG_DEC))[(size_t)u * 64 + d0 + j] = __expf(bl[j]);
        }
    }
    __syncthreads();
    const int lr = lane & 15, lq = lane >> 4;
    for (int ti = wave; ti < 10; ti += NWAVES) {
        const int I = ti < 1 ? 0 : ti < 3 ? 1 : ti < 6 ? 2 : 3, J = ti - (I * (I + 1)) / 2;
        f32x4v acc = {0.f, 0.f, 0.f, 0.f};
#pragma unroll
        for (int kk = 0; kk < 2; ++kk) { const bf16x8 a = *(const LAS bf16x8*)(QS + (16 * I + lr) * 72 + 32 * kk + 8 * lq), bb = *(const LAS bf16x8*)(KS + I * 4608 + (16 * J + lr) * 72 + 32 * kk + 8 * lq);
            acc = MFMA16(a, bb, acc); }
#pragma unroll
        for (int r = 0; r < 4; ++r) { const int tt = 16 * I + 4 * lq + r, ss = 16 * J + lr; AM[tt * 72 + ss] = (bf16)f2bf(ss <= tt ? acc[r] : 0.f); }
    }
    __syncthreads();
    if (wave < 4) {
#pragma unroll
        for (int et = 0; et < 8; ++et) { f32x4v acc = {0.f, 0.f, 0.f, 0.f};
#pragma unroll
            for (int kk = 0; kk < 2; ++kk) { const bf16x8 a = *(const LAS bf16x8*)(AM + (16 * wave + lr) * 72 + 32 * kk + 8 * lq), bb = *(const LAS bf16x8*)(VT + (16 * et + lr) * 72 + 32 * kk + 8 * lq);
                acc = MFMA16(bb, a, acc); }
            ((f32x4v*)(ws + HG_OI))[(((size_t)u * 4 + wave) * 8 + et) * 64 + lane] = acc; }
    } else {
        const int dI = wave - 4;
#pragma unroll
        for (int et = 0; et < 8; ++et) { f32x4v acc = {0.f, 0.f, 0.f, 0.f};
#pragma unroll
            for (int kk = 0; kk < 2; ++kk) { const bf16x8 a = *(const LAS bf16x8*)(KT + (16 * dI + lr) * 72 + 32 * kk + 8 * lq), bb = *(const LAS bf16x8*)(VT + (16 * et + lr) * 72 + 32 * kk + 8 * lq);
                acc = MFMA16(a, bb, acc); }
            *(f32x4v*)((float*)(ws + HG_UT) + ((size_t)u * 128 + 16 * et + lr) * 64 + 16 * dI + 4 * lq) = acc; }
    }
    __syncthreads();
}

__device__ __forceinline__ void hgrn_scan(const Params& P) {
    unsigned char* ws = P.ws;
    for (int ch = blockIdx.x; ch < 256; ch += gridDim.x) {
        const int gid = ch * NTHR + threadIdx.x;
        const int bh = gid >> 13, ed = gid & 8191, d = gid & 63;
        const float* ut = (const float*)(ws + HG_UT) + (size_t)bh * 64 * 8192 + ed; const float* dec = (const float*)(ws + HG_DEC) + (size_t)bh * 64 * 64 + d;
        bf16* st = (bf16*)(ws + HG_ST) + (size_t)bh * 64 * 8192 + ed;
        float sreg = 0.f;
        float un[16], dn[16];
#pragma unroll
        for (int c = 0; c < 16; ++c) { un[c] = ut[(size_t)c * 8192]; dn[c] = dec[c * 64]; }
#pragma unroll
        for (int c0 = 0; c0 < 64; c0 += 16) {
            float uu[16], dc[16];
#pragma unroll
            for (int c = 0; c < 16; ++c) { uu[c] = un[c]; dc[c] = dn[c]; }
            if (c0 + 16 < 64) {
#pragma unroll
                for (int c = 0; c < 16; ++c) { un[c] = ut[(size_t)(c0 + 16 + c) * 8192]; dn[c] = dec[(c0 + 16 + c) * 64]; }
            }
#pragma unroll
            for (int c = 0; c < 16; ++c) { __hip_atomic_store(st + (size_t)(c0 + c) * 8192, (bf16)f2bf(sreg), __ATOMIC_RELAXED, __HIP_MEMORY_SCOPE_AGENT); sreg = dc[c] * sreg + uu[c]; }
        }
        PROBE_STAMP(P, 45);
        asm volatile("s_waitcnt vmcnt(0)" ::: "memory");
        __syncthreads();
        PROBE_STAMP(P, 46);
        if (threadIdx.x == 0) __hip_atomic_fetch_add((int*)(ctl() + HG_FLAG) + (ch >> 4), 1, __ATOMIC_RELAXED, __HIP_MEMORY_SCOPE_AGENT);
    }
}

__device__ __forceinline__ void hgrn_wait_scans(const Params& P) {
    if (threadIdx.x < 64) {
        const int* flag = (const int*)(ctl() + HG_FLAG) + (threadIdx.x & 15); unsigned spins = 0;
        while (!__all(__hip_atomic_load(flag, __ATOMIC_RELAXED, __HIP_MEMORY_SCOPE_AGENT) >= 16)) { __builtin_amdgcn_s_sleep(2); if (++spins > (1u << 22)) break; }
        __builtin_amdgcn_fence(__ATOMIC_ACQUIRE, "agent");
        asm volatile("s_waitcnt vmcnt(0)" ::: "memory");
    }
    __syncthreads();
}
struct HOut { int u, I, b, c, h; size_t trow; };
__device__ __forceinline__ HOut hout_of(int task, int lr) { HOut t; t.u = task >> 2; t.I = task & 3; const int bh = t.u >> 6; t.c = t.u & 63; t.b = bh >> 2; t.h = bh & 3;
    t.trow = (size_t)t.b * S + t.c * 64 + 16 * t.I + lr; return t; }
__device__ __forceinline__ void hout_load(const Params& P, const HOut& t, int lane, u32x2 (&gbv)[8], f32x4v (&acc)[8], bf16x8 (&a)[2]) {
    unsigned char* ws = P.ws; const int lr = lane & 15, lq = lane >> 4;
#pragma unroll
    for (int et = 0; et < 8; ++et) gbv[et] = *(const u32x2*)((const bf16*)(ws + N_GB) + t.trow * 512 + t.h * 128 + 16 * et + 4 * lq);
#pragma unroll
    for (int et = 0; et < 8; ++et) acc[et] = ((const f32x4v*)(ws + HG_OI))[(((size_t)t.u * 4 + t.I) * 8 + et) * 64 + lane];
#pragma unroll
    for (int kk = 0; kk < 2; ++kk) a[kk] = *(const bf16x8*)((const bf16*)(ws + HG_QT) + ((size_t)t.u * 64 + 16 * t.I + lr) * 64 + 32 * kk + 8 * lq);
}
__device__ __forceinline__ void hout_finish(const Params& P, const HOut& t, int lane, const u32x2 (&gbv)[8], f32x4v (&acc)[8], const bf16x8 (&a)[2]) {
    unsigned char* ws = P.ws; const int lr = lane & 15, lq = lane >> 4;
#pragma unroll
    for (int et = 0; et < 8; ++et)
#pragma unroll
        for (int kk = 0; kk < 2; ++kk) { const bf16x8 bb = *(const bf16x8*)((const bf16*)(ws + HG_ST) + ((size_t)t.u * 128 + 16 * et + lr) * 64 + 32 * kk + 8 * lq); acc[et] = MFMA16(bb, a[kk], acc[et]); }
    float ss = 0.f;
#pragma unroll
    for (int et = 0; et < 8; ++et)
#pragma unroll
        for (int r = 0; r < 4; ++r) ss += acc[et][r] * acc[et][r];
    ss += __shfl_xor(ss, 16); ss += __shfl_xor(ss, 32);
    const float rstd = rsqrtf(ss * (1.f / 128.f) + 1e-6f);
#pragma unroll
    for (int et = 0; et < 8; ++et) { const f32x4v g = *(const f32x4v*)(P.in[7] + 16 * et + 4 * lq);
        float o[4];
#pragma unroll
        for (int r = 0; r < 4; ++r) { const unsigned w = gbv[et][r >> 1]; const float gb = __builtin_bit_cast(float, (r & 1) ? (w & 0xffff0000u) : (w << 16));
            o[r] = acc[et][r] * rstd * g[r] * gb * __builtin_amdgcn_rcpf(1.f + __expf(-gb)); }
        u32x2 ow; ow.x = pk2(o[0], o[1]); ow.y = pk2(o[2], o[3]);
        *(u32x2*)((bf16*)(ws + N_MIX) + t.trow * 1024 + 512 + t.h * 128 + 16 * et + 4 * lq) = ow; }
}
__device__ __forceinline__ void hout_finish_bb(const Params& P, const HOut& t, int lane, const u32x2 (&gbv)[8], f32x4v (&acc)[8], const bf16x8 (&a)[2], const bf16x8 (&bb)[8][2]) {
    unsigned char* ws = P.ws; const int lq = lane >> 4;
#pragma unroll
    for (int et = 0; et < 8; ++et)
#pragma unroll
        for (int kk = 0; kk < 2; ++kk) acc[et] = MFMA16(bb[et][kk], a[kk], acc[et]);
    float ss = 0.f;
#pragma unroll
    for (int et = 0; et < 8; ++et)
#pragma unroll
        for (int r = 0; r < 4; ++r) ss += acc[et][r] * acc[et][r];
    ss += __shfl_xor(ss, 16); ss += __shfl_xor(ss, 32);
    const float rstd = rsqrtf(ss * (1.f / 128.f) + 1e-6f);
#pragma unroll
    for (int et = 0; et < 8; ++et) { const f32x4v g = *(const f32x4v*)(P.in[7] + 16 * et + 4 * lq);
        float o[4];
#pragma unroll
        for (int r = 0; r < 4; ++r) { const unsigned w = gbv[et][r >> 1]; const float gb = __builtin_bit_cast(float, (r & 1) ? (w & 0xffff0000u) : (w << 16));
            o[r] = acc[et][r] * rstd * g[r] * gb * __builtin_amdgcn_rcpf(1.f + __expf(-gb)); }
        u32x2 ow; ow.x = pk2(o[0], o[1]); ow.y = pk2(o[2], o[3]);
        *(u32x2*)((bf16*)(ws + N_MIX) + t.trow * 1024 + 512 + t.h * 128 + 16 * et + 4 * lq) = ow; }
}
__device__ __forceinline__ void hgrn_out_unit2(const Params& P, int u, int ip, int lane) {
    const int lr = lane & 15, lq = lane >> 4;
    const HOut t0 = hout_of(u * 4 + 2 * ip, lr), t1 = hout_of(u * 4 + 2 * ip + 1, lr);
    u32x2 g0[8], g1[8]; f32x4v c0[8], c1[8]; bf16x8 a0[2], a1[2], bb[8][2];
#pragma unroll
    for (int et = 0; et < 8; ++et)
#pragma unroll
        for (int kk = 0; kk < 2; ++kk) bb[et][kk] = *(const bf16x8*)((const bf16*)(P.ws + HG_ST) + ((size_t)u * 128 + 16 * et + lr) * 64 + 32 * kk + 8 * lq);
    hout_load(P, t0, lane, g0, c0, a0); hout_load(P, t1, lane, g1, c1, a1);
    hout_finish_bb(P, t0, lane, g0, c0, a0, bb); hout_finish_bb(P, t1, lane, g1, c1, a1, bb);
}
__device__ __forceinline__ void hgrn_out_pair(const Params& P, int task0, int task1, int lane) {
    const int lr = lane & 15;
    const HOut t0 = hout_of(task0, lr), t1 = hout_of(task1, lr);
    u32x2 g0[8], g1[8]; f32x4v c0[8], c1[8]; bf16x8 a0[2], a1[2];
    hout_load(P, t0, lane, g0, c0, a0); hout_load(P, t1, lane, g1, c1, a1);
    hout_finish(P, t0, lane, g0, c0, a0); hout_finish(P, t1, lane, g1, c1, a1);
}
__device__ __forceinline__ void hgrn_out_task(const Params& P, int task, int lane) {
    const HOut t = hout_of(task, lane & 15); u32x2 g[8]; f32x4v c[8]; bf16x8 a[2];
    hout_load(P, t, lane, g, c, a); hout_finish(P, t, lane, g, c, a);
}
}
namespace mk {
template <int K>
__device__ __forceinline__ void run_phase(const Params& P, LAS unsigned char* lds, int vcu, int G, int bx, int wave, int lane) {
    if constexpr (K == 0) phase0(P, lds, vcu, G, wave, lane);
    if constexpr (K == 1) phase1a(P, vcu, G, wave, lane);
    if constexpr (K == 2) {
        pg8::Gemm g{(const pg8::bf16_t*)(P.ws + N_HB), (const pg8::bf16_t*)(P.ws + N_WTIN), T, NPAD, D};
        pg8::StaticOrder So; So.init(T, NPAD, G, bx);
        EpiProj E{P.ws};
        pg8::gemm_phase<EpiProj, pg8::StaticOrder, true, true>(lds, g, So, E);
        PROBE_STAMP(P, 20);
        if (G == 256 && bx >= 128) transpose_moe<0>(P, lds, 0, moe_w1_early(G), (bx - 128) * NWAVES + wave, 128 * NWAVES, wave, lane);
        PROBE_STAMP(P, 21);
    }
    if constexpr (K == 3) { phase_index(P, lds, vcu, G, wave, lane, P.mask_old); __syncthreads(); PROBE_STAMP(P, 30);
        int* ctr = (int*)(ctl() + 4096); LAS int* slot = (LAS int*)(lds + LDS_BYTES - 128);
        int tk = 0; if (threadIdx.x == 0) tk = __hip_atomic_fetch_add(ctr, 1, __ATOMIC_RELAXED, __HIP_MEMORY_SCOPE_AGENT);
        for (;;) {
            if (threadIdx.x == 0) *slot = tk;
            __syncthreads();
            const int u = *slot;
            __syncthreads();
            if (u >= 1024) break;
            if (threadIdx.x == 0) tk = __hip_atomic_fetch_add(ctr, 1, __ATOMIC_RELAXED, __HIP_MEMORY_SCOPE_AGENT);
            hgrn_local_unit(P, lds, u, wave, lane);
        } }
    if constexpr (K == 4) { hgrn_scan(P); PROBE_STAMP(P, 40); phase_attn(P, lds, vcu, G, wave, lane); PROBE_STAMP(P, 41); hgrn_wait_scans(P); PROBE_STAMP(P, 42); { const int tk0 = vcu * NWAVES + wave, st = G * NWAVES; if (st == 2048) hgrn_out_unit2(P, tk0 >> 1, tk0 & 1, lane); else for (int tk = tk0; tk < 4096; tk += st) hgrn_out_task(P, tk, lane); } }
    if constexpr (K == 5) {
        pg8::Gemm g{(const pg8::bf16_t*)(P.ws + N_MIX), (const pg8::bf16_t*)(P.ws + N_WTOUT), T, D, D};
        pg8::StaticOrder So; So.init(T, D, G, bx);
        EpiX1 E{P.in[0], (const float*)(P.ws + N_MOD), (float*)(P.ws + N_X1)};
        pg8::gemm_phase<EpiX1, pg8::StaticOrder, true, true>(lds, g, So, E);
        __syncthreads();
        route_fill(P, lds);
    }
    if constexpr (K == 6) phase_route(P, lds, vcu, G, wave, lane);
    if constexpr (K == 7) { phase_scatter(P, lds, vcu, G, wave, lane); }
    if constexpr (K == 8) {
        LAS int* ps = (LAS int*)(lds + LDS_MISC); LAS int* blke = ps + 64;
        const int nrb = moe_tables((const int*)ctl(), ps, blke);
        PROBE_STAMP(P, 60);
        const int n1 = nrb * 8, idle = (256 - n1 % 256) % 256, extra = (nrb * 4) % 256, mv = (G == 256 && extra <= idle && extra <= 256) ? extra : 0;
        pg8::Gemm g{(const pg8::bf16_t*)(P.ws + N_HB), (const pg8::bf16_t*)(P.ws + N_W1T), NROWS, 32 * 2048, D};
        MoeOrder<8, true, true> So{blke, n1, G, bx, (const int*)(P.ws + N_TOK), mv, (int*)(ctl() + MOE_READY)};
        EpiMoe E{EpiSwiglu{P.in[14], (bf16*)(P.ws + N_ACT), (mv + 3) >> 2}, EpiY{P.in[16], (bf16*)(P.ws + N_Y)}};
        pg8::gemm_phase<EpiMoe, MoeOrder<8, true, true>, true, true>(lds, g, So, E);
    }
    if constexpr (K == 9) {
        LAS int* ps = (LAS int*)(lds + LDS_MISC); LAS int* blke = ps + 64;
        const int nrb = ps[32] >> 8;
        const int n1 = nrb * 8, idle = (256 - n1 % 256) % 256, extra = (nrb * 4) % 256, mv = (G == 256 && extra <= idle && extra <= 256) ? extra : 0;
        pg8::Gemm g{(const pg8::bf16_t*)(P.ws + N_ACT), (const pg8::bf16_t*)(P.ws + N_W2T), NROWS, 32 * 1024, D};
        MoeOrder<4, false, false> So{blke, nrb * 4, G, vcu, nullptr, mv, nullptr};
        EpiY E{P.in[16], (bf16*)(P.ws + N_Y)};
        pg8::gemm_phase<EpiY, MoeOrder<4, false, false>, true, true>(lds, g, So, E);
    }
    if constexpr (K == 10) phase_final(P, vcu, G, wave, lane);

}
__global__ void __launch_bounds__(NTHR, 2) mk_fwd(Params P) {
    extern __shared__ __attribute__((aligned(16))) unsigned char lds_raw[];
    LAS unsigned char* lds = (LAS unsigned char*)lds_raw;
    const int tid = threadIdx.x, lane = tid & 63, wave = __builtin_amdgcn_readfirstlane(tid >> 6);
    const int G = gridDim.x; const int bx = blockIdx.x; const int vcu = (G % 8 == 0) ? (bx % 8) * (G / 8) + bx / 8 : bx;
    volatile LAS unsigned* xst = (volatile LAS unsigned*)(lds + LDS_BYTES - 256);
    if (tid < 2) xst[tid] = 0u;
#ifdef PROBE_PID
    if (tid < 8) ((volatile LAS unsigned long long*)(lds + LDS_BYTES - 64))[tid] = 0ull;
#endif
    __syncthreads();
    XcdBarrier xbar = xcd_barrier_post((unsigned*)(ctl() + 8192), xst);
#define RUN(k) do { PROBE_STAMP(P, k); if ((P.prog >> (k)) & 1ull) run_phase<k>(P, lds, vcu, G, bx, wave, lane); } while (0)
#define SYNC0() xcd_barrier(xbar)
#define SYNC() xcd_barrier(xbar)
     RUN(0); SYNC0(); RUN(1); SYNC(); RUN(2); SYNC(); RUN(3); SYNC(); RUN(4); SYNC(); RUN(5); SYNC(); RUN(6); SYNC(); RUN(7); SYNC(); RUN(8); SYNC(); RUN(9); SYNC(); RUN(10);
#ifdef PROBE_A
    PROBE_STAMP(P, 11);
#ifdef PROBE_PID
    if (threadIdx.x == 0) { unsigned long long* st_ = (unsigned long long*)(P.ws + N_CTL + 131072); st_[2 * blockIdx.x] = 0ull; st_[2 * blockIdx.x + 1] = ((volatile LAS unsigned long long*)(lds + LDS_BYTES - 64))[PROBE_LSEL]; }
#endif
    xcd_barrier(xbar);
    if (blockIdx.x == 0 && threadIdx.x == 0) { unsigned long long* st_ = (unsigned long long*)(P.ws + N_CTL + 131072); unsigned long long amin = ~0ull, bmin = ~0ull, bmax = 0ull;
        for (int i = 0; i < (int)gridDim.x; ++i) { const unsigned long long a_ = __hip_atomic_load(st_ + 2 * i, __ATOMIC_RELAXED, __HIP_MEMORY_SCOPE_AGENT), b_ = __hip_atomic_load(st_ + 2 * i + 1, __ATOMIC_RELAXED, __HIP_MEMORY_SCOPE_AGENT);
            if (PROBE_MODE == 0 && i != PROBE_BLK) continue; amin = a_ < amin ? a_ : amin; bmin = b_ < bmin ? b_ : bmin; bmax = b_ > bmax ? b_ : bmax; }
        const unsigned long long d_ = ((PROBE_MODE == 2 ? bmin : bmax) - amin) * PROBE_MAG, t0_ = wall_clock64();
        while (wall_clock64() - t0_ < d_) __builtin_amdgcn_s_sleep(16); }
#endif
#undef RUN
#undef SYNC
#undef SYNC0
    __syncthreads();
    if (threadIdx.x == 0) xst[0] = (__hip_atomic_fetch_add((unsigned*)(ctl() + CTL_EXIT), 1u, __ATOMIC_RELAXED, __HIP_MEMORY_SCOPE_AGENT) == (unsigned)gridDim.x - 1u) ? 1u : 0u;
    __syncthreads();
    if (xst[0]) for (int i = threadIdx.x; i < 8192; i += NTHR) __hip_atomic_store(g_ctl + i, 0u, __ATOMIC_RELAXED, __HIP_MEMORY_SCOPE_AGENT);
}
}
extern "C" void kernel_launch(void* const* d_in, const int* in_sizes, int n_in, void* d_out, int out_size, void* d_ws, size_t ws_size, hipStream_t stream) {
    if (ws_size < mk::N_END_D) { fprintf(stderr, "kernel_launch: workspace too small (%zu)\n", ws_size); return; }
    static int grid = 0;
    if (!grid) {
        int dev = 0, cus = 0, per_cu = 0;
        (void)hipGetDevice(&dev); (void)hipDeviceGetAttribute(&cus, hipDeviceAttributeMultiprocessorCount, dev);
        (void)hipFuncSetAttribute((const void*)mk::mk_fwd, hipFuncAttributeMaxDynamicSharedMemorySize, mk::LDS_BYTES);
        (void)hipOccupancyMaxActiveBlocksPerMultiprocessor(&per_cu, (const void*)mk::mk_fwd, mk::NTHR, mk::LDS_BYTES);
        grid = 256;
        if (cus < 256 || per_cu < 1) { fprintf(stderr, "kernel_launch: needs 256 CUs with one resident 512-thread workgroup each (have %d CUs, %d per CU); nothing launched\n", cus, per_cu); grid = -1; }
    }
    if (grid < 0) return;
    mk::Params P{};
    for (int i = 0; i < 18; ++i) P.in[i] = (const float*)d_in[i];
    P.out = (float*)d_out; P.ws = (unsigned char*)d_ws; P.mask_old = nullptr;  P.prog = 0xfffull; P.nprog = 0;
    void* args[] = {&P};
    hipError_t e = hipLaunchCooperativeKernel((const void*)mk::mk_fwd, dim3(grid), dim3(mk::NTHR), args, mk::LDS_BYTES, stream);
    if (e != hipSuccess) fprintf(stderr, "cooperative launch failed: %s (grid %d)\n", hipGetErrorString(e), grid);
}
```
